# Optimizing an MI355X kernel written in HIP

```python
import math
import jax, jax.numpy as jnp
from jax import lax
import numpy as np


D_MODEL = 1024
BATCH = 4
SEQ = 4096
DEPTH = 1
DEC_BATCH = 32
DEC_SEQ = 8
PAST_LEN = 8192
PAGE_SIZE = 128

H_RET = 8
DK_RET = 64
DV_RET = 64
D_RET = H_RET * DV_RET
RET_CHUNK = 128
H_ATT = 8
HD_ATT = 64
D_ATT = H_ATT * HD_ATT
BRANCHES = ((128, 1), (512, 4), (2048, 16))
MAX_WINDOW = 2048
Q_BLOCK = 128
D_MIX = D_RET + D_ATT
D_IN = 2 * H_RET * DK_RET + 2 * D_RET + 3 * D_ATT
D_FF = 2816
CONV_W = 3
EPS = 1e-6

kernel_name = 'hybrid_retention_dilated_attn_convffn_step'


def _rmsnorm(x, w):
    xf = x.astype(jnp.float32)
    y = xf * lax.rsqrt(jnp.mean(xf * xf, axis=-1, keepdims=True) + EPS)
    return (y * w.astype(jnp.float32)).astype(x.dtype)


def _retention(q, k, v, s0):
    B, T = q.shape[0], q.shape[1]
    C = math.gcd(T, RET_CHUNK)
    nc = T // C
    lg = jnp.log1p(-jnp.exp2(-5.0 - jnp.arange(H_RET, dtype=jnp.float32)))
    i = jnp.arange(C, dtype=jnp.float32)
    diff = i[:, None] - i[None, :]
    intra = jnp.where(diff >= 0, jnp.exp(lg[:, None, None] * jnp.maximum(diff, 0.0)), 0.0)
    q_dec = jnp.exp(lg[None, :] * (i[:, None] + 1.0))[None, :, :, None]
    k_dec = jnp.exp(lg[None, :] * (C - 1.0 - i[:, None]))[None, :, :, None]
    c_dec = jnp.exp(lg * C)[None, :, None, None]

    def to_chunks(a):
        return a.astype(jnp.float32).reshape(B, nc, C, H_RET, a.shape[-1]).swapaxes(0, 1)

    qc = to_chunks(q)
    kc = to_chunks(k) * (DK_RET ** -0.5)
    vc = to_chunks(v)

    def step(S, inp):
        qi, ki, vi = inp
        sc = jnp.einsum('bihd,bjhd->bhij', qi, ki) * intra
        o = jnp.einsum('bhij,bjhe->bihe', sc, vi) + jnp.einsum('bihd,bhde->bihe', qi, S) * q_dec
        S = S * c_dec + jnp.einsum('bjhd,bjhe->bhde', ki * k_dec, vi)
        return S, o

    S, o = lax.scan(step, s0.astype(jnp.float32), (qc, kc, vc))
    o = o.swapaxes(0, 1).reshape(B, T, H_RET, DV_RET)
    return o, S


def _dilated_attention(q, q_pos, k_all, v_all, k_start):
    slopes = jnp.exp2(-8.0 * jnp.arange(1, H_ATT + 1, dtype=jnp.float32) / H_ATT)
    qf = q.astype(jnp.float32) * (HD_ATT ** -0.5)
    ms, dens, nums = [], [], []
    for window, dil in BRANCHES:
        dist = dil * jnp.arange(window // dil + 1, dtype=jnp.int32)
        local = q_pos[:, None] - dist[None, :] - k_start
        valid = local >= 0
        idx = jnp.maximum(local, 0)
        kg = k_all[:, idx].astype(jnp.float32)
        vg = v_all[:, idx].astype(jnp.float32)
        s = jnp.einsum('bqhd,bqnhd->bhqn', qf, kg) - slopes[:, None, None] * dist.astype(jnp.float32)
        s = jnp.where(valid, s, -jnp.inf)
        m = jnp.max(s, axis=-1)
        p = jnp.exp(s - m[..., None])
        ms.append(m)
        dens.append(jnp.sum(p, axis=-1))
        nums.append(jnp.einsum('bhqn,bqnhd->bqhd', p, vg))
    M = ms[0]
    for m in ms[1:]:
        M = jnp.maximum(M, m)
    num = 0.0
    den = 0.0
    for m, dn, nm in zip(ms, dens, nums):
        sc = jnp.exp(m - M)
        num = num + nm * sc.transpose(0, 2, 1)[..., None]
        den = den + dn * sc
    return num / den.transpose(0, 2, 1)[..., None]


def _layer(x, ret_s0, win_k, win_v, conv_s0, pos0, norm1_w, w_in, ret_gn_w, ret_gn_b, w_out,
           norm2_w, w_up, conv_w, conv_b, w_down):
    B, T = x.shape[0], x.shape[1]
    h = _rmsnorm(x, norm1_w)
    proj = h @ w_in
    sizes = (H_RET * DK_RET, H_RET * DK_RET, D_RET, D_RET, D_ATT, D_ATT, D_ATT)
    points = [sum(sizes[:j]) for j in range(1, len(sizes))]
    rq, rk, rv, rg, aq, ak, av = jnp.split(proj, points, axis=-1)

    ro, ret_s = _retention(rq.reshape(B, T, H_RET, DK_RET), rk.reshape(B, T, H_RET, DK_RET),
                           rv.reshape(B, T, H_RET, DV_RET), ret_s0)
    mu = jnp.mean(ro, axis=-1, keepdims=True)
    var = jnp.mean(jnp.square(ro - mu), axis=-1, keepdims=True)
    ro = ((ro - mu) * lax.rsqrt(var + EPS)).reshape(B, T, D_RET)
    ro = ro * ret_gn_w.astype(jnp.float32) + ret_gn_b.astype(jnp.float32)
    ro = jax.nn.silu(rg.astype(jnp.float32)) * ro

    ak = ak.reshape(B, T, H_ATT, HD_ATT)
    av = av.reshape(B, T, H_ATT, HD_ATT)
    k_all = jnp.concatenate([win_k.astype(ak.dtype), ak], axis=1)
    v_all = jnp.concatenate([win_v.astype(av.dtype), av], axis=1)
    k_start = pos0 - win_k.shape[1]
    qb = math.gcd(T, Q_BLOCK)
    nb = T // qb
    q_blocks = aq.reshape(B, nb, qb, H_ATT, HD_ATT).swapaxes(0, 1)
    pos_blocks = (pos0 + jnp.arange(T, dtype=jnp.int32)).reshape(nb, qb)
    ao = lax.map(lambda blk: _dilated_attention(blk[0], blk[1], k_all, v_all, k_start),
                 (q_blocks, pos_blocks))
    ao = ao.swapaxes(0, 1).reshape(B, T, D_ATT)
    keep = min(MAX_WINDOW, k_all.shape[1])

    x = x + jnp.concatenate([ro, ao], axis=-1).astype(x.dtype) @ w_out

    h = _rmsnorm(x, norm2_w)
    ua, ub = jnp.split(h @ w_up, [D_FF], axis=-1)
    buf = jnp.concatenate([conv_s0.astype(ua.dtype), ua], axis=1)
    conv = conv_b
    for j in range(CONV_W):
        conv = conv + buf[:, j:j + T] * conv_w[j]
    x = x + (jax.nn.silu(conv) * ub) @ w_down
    return (x, ret_s.astype(ret_s0.dtype), k_all[:, -keep:], v_all[:, -keep:], buf[:, -(CONV_W - 1):])


def setup_inputs(seed: int = 0) -> dict:
    key = jax.random.key(seed)
    ks = jax.random.split(key, 20)
    win_rows = min(MAX_WINDOW, PAST_LEN)
    nrm = jax.random.normal
    f32 = jnp.float32
    return {
        'x_prompt': nrm(ks[0], (BATCH, SEQ, D_MODEL), f32),
        'x_sample': nrm(ks[1], (DEC_BATCH, DEC_SEQ, D_MODEL), f32),
        'state_ret': 0.5 * nrm(ks[2], (DEC_BATCH, H_RET, DK_RET, DV_RET), f32),
        'cache_win_k': nrm(ks[3], (DEC_BATCH, win_rows, H_ATT, HD_ATT), f32),
        'cache_win_v': nrm(ks[4], (DEC_BATCH, win_rows, H_ATT, HD_ATT), f32),
        'state_conv': nrm(ks[5], (DEC_BATCH, CONV_W - 1, D_FF), f32),
        'norm1_w': 1.0 + 0.02 * nrm(ks[6], (D_MODEL,), f32),
        'w_in': nrm(ks[7], (D_MODEL, D_IN), f32) * D_MODEL ** -0.5,
        'ret_gn_w': 1.0 + 0.02 * nrm(ks[8], (D_RET,), f32),
        'ret_gn_b': 0.02 * nrm(ks[9], (D_RET,), f32),
        'w_out': nrm(ks[10], (D_MIX, D_MODEL), f32) * D_MIX ** -0.5,
        'norm2_w': 1.0 + 0.02 * nrm(ks[11], (D_MODEL,), f32),
        'w_up': nrm(ks[12], (D_MODEL, 2 * D_FF), f32) * D_MODEL ** -0.5,
        'conv_w': nrm(ks[13], (CONV_W, D_FF), f32) * CONV_W ** -0.5,
        'conv_b': 0.02 * nrm(ks[14], (D_FF,), f32),
        'w_down': nrm(ks[15], (D_FF, D_MODEL), f32) * D_FF ** -0.5,
        'normf_w': 1.0 + 0.02 * nrm(ks[16], (D_MODEL,), f32),
    }


def reference(x_prompt, x_sample, state_ret, cache_win_k, cache_win_v, state_conv, norm1_w, w_in,
              ret_gn_w, ret_gn_b, w_out, norm2_w, w_up, conv_w, conv_b, w_down, normf_w):
    weights = (norm1_w, w_in, ret_gn_w, ret_gn_b, w_out, norm2_w, w_up, conv_w, conv_b, w_down)
    b = x_prompt.shape[0]
    zero_ret = jnp.zeros((b, H_RET, DK_RET, DV_RET), x_prompt.dtype)
    empty_kv = jnp.zeros((b, 0, H_ATT, HD_ATT), x_prompt.dtype)
    zero_conv = jnp.zeros((b, CONV_W - 1, D_FF), x_prompt.dtype)
    hp, hs = x_prompt, x_sample
    for _ in range(DEPTH):
        hp, ret_p, wk_p, wv_p, conv_p = _layer(hp, zero_ret, empty_kv, empty_kv, zero_conv, 0, *weights)
        hs, ret_s, wk_s, wv_s, conv_s = _layer(hs, state_ret, cache_win_k, cache_win_v, state_conv,
                                               PAST_LEN, *weights)
    y_prompt = _rmsnorm(hp, normf_w)
    y_sample = _rmsnorm(hs, normf_w)
    return (y_prompt, y_sample, ret_p, ret_s, wk_p, wv_p, wk_s, wv_s, conv_p, conv_s)
```

```cpp
#include <hip/hip_runtime.h>
#include <hip/hip_cooperative_groups.h>
#include <cstdio>
#include <cstdint>
namespace cg = cooperative_groups;

#define LAS __attribute__((address_space(3)))
typedef unsigned short bf16_t;
typedef short bf16x8 __attribute__((ext_vector_type(8)));
typedef short s16x4 __attribute__((ext_vector_type(4)));
typedef float f32x4 __attribute__((ext_vector_type(4)));
typedef float f32x2 __attribute__((ext_vector_type(2)));
typedef unsigned u32x4 __attribute__((ext_vector_type(4)));
typedef unsigned u32x2 __attribute__((ext_vector_type(2)));
typedef __bf16 bf16x2_t __attribute__((ext_vector_type(2)));
typedef LAS unsigned char* ldsp;

constexpr int DM = 1024, NB = 4, SEQ = 4096, MP = NB * SEQ, SBAT = 32, STOK = 8, MS = SBAT * STOK, MT = MP + MS;
constexpr int DIN = 3584, DFF = 2816, NUP = 2 * DFF;
constexpr int C_RQ = 0, C_RK = 512, C_RV = 1024, C_RG = 1536, C_AQ = 2048, C_AK = 2560, C_AV = 3072;
constexpr int WINR = 2048;
constexpr float EPS = 1e-6f, LOG2E = 1.4426950408889634f;
constexpr size_t O_Y = 0, O_RETP = 17039360, O_RETS = 17170432, O_WKP = 18219008, O_WVP = 22413312, O_WKS = 26607616, O_WVS = 60162048,
                 O_CVP = 93716480, O_CVS = 93739008;
constexpr size_t MiB = 1u << 20;
constexpr size_t WS_WIN = 0, WS_WOUT = 8 * MiB, WS_WUP = 10 * MiB, WS_WDN = 22 * MiB, WS_RSQ = 28 * MiB, WS_H1 = 32 * MiB, WS_PROJ = 66 * MiB,
                 WS_U = 180 * MiB, WS_SIN = 196 * MiB, WS_ATTO = 204 * MiB, WS_ATTML = 252 * MiB, WS_MIX = 256 * MiB, WS_X1 = 290 * MiB,
                 WS_X1B = 356 * MiB, WS_G = 392 * MiB, WS_END = 484 * MiB;
constexpr size_t WS_BAR = 30 * MiB, WS_CNT = WS_BAR + 16384, BAR_ZERO_BYTES = 16384 + 65 * 256, WS_RSQ2 = WS_RSQ + 128 * 1024;
constexpr int X1B_PB = 4216, X1B_SROW = 16872;
constexpr int LDS_BYTES = 147456;
#ifndef DBL_MASK
#define DBL_MASK 0
#endif
#define REPS(k) for (int rep_ = 0; rep_ < (((DBL_MASK) >> (k)) & 1) + 1; ++rep_)

__device__ __forceinline__ float bf2f(bf16_t b) { return __uint_as_float((unsigned)b << 16); }
__device__ __forceinline__ unsigned pk2(float lo, float hi) { f32x2 v = {lo, hi}; bf16x2_t b = __builtin_convertvector(v, bf16x2_t); return __builtin_bit_cast(unsigned, b); }
__device__ __forceinline__ bf16_t f2bf(float f) { return (bf16_t)(pk2(f, 0.f) & 0xffffu); }
__device__ __forceinline__ float ex2(float x) { return __builtin_amdgcn_exp2f(x); }
__device__ __forceinline__ float silu(float x) { return x * __builtin_amdgcn_rcpf(1.f + ex2(-x * LOG2E)); }
__device__ __forceinline__ float wave_sum(float v) {
#pragma unroll
    for (int o = 1; o < 64; o <<= 1) v += __shfl_xor(v, o);
    return v;
}
__device__ __forceinline__ float wave_max(float v) {
#pragma unroll
    for (int o = 1; o < 64; o <<= 1) v = fmaxf(v, __shfl_xor(v, o));
    return v;
}
#define MFMA16(a, b, c) __builtin_amdgcn_mfma_f32_16x16x32_bf16((a), (b), (c), 0, 0, 0)
typedef short v4i16_t __attribute__((ext_vector_type(4)));
__device__ __forceinline__ s16x4 lds_tr4(ldsp p) { return __builtin_bit_cast(s16x4, __builtin_amdgcn_ds_read_tr16_b64_v4i16((LAS v4i16_t*)p)); }
__device__ __forceinline__ bf16x8 tr_frag(ldsp img, int stride, int r0, int r1, int c0, int fr) {
    const int q = fr >> 2, p = fr & 3;
    const s16x4 lo = lds_tr4(img + (r0 + q) * stride + (c0 + 4 * p) * 2), hi = lds_tr4(img + (r1 + q) * stride + (c0 + 4 * p) * 2);
    return __builtin_shufflevector(lo, hi, 0, 1, 2, 3, 4, 5, 6, 7);
}

namespace pg8 {
constexpr int BM = 256, BK = 64, HALF = 128, HTB = HALF * BK * 2, STAGE_BYTES = 8 * HTB, NXCD = 8, WGM = 8;
__host__ __device__ __forceinline__ int lds_byte(int r, int c) { const int st = (r >> 4) * 2 + (c >> 5), rr = r & 15, cc = c & 31, ob = rr * 64 + cc * 2; return st * 1024 + (ob ^ (((ob >> 9) & 1) << 5)); }
__host__ __device__ __forceinline__ void stage_rc(int b, int& R, int& C) { const int st = b / 1024, sb = b % 1024, swz = sb ^ (((sb >> 9) & 1) << 5); R = (st >> 1) * 16 + swz / 64; C = (st & 1) * 32 + (swz % 64) / 2; }
__host__ __device__ __forceinline__ int perm32(int rho) { const int n = rho >> 4, i = rho & 15; return 8 * (i >> 2) + 4 * n + (i & 3); }
struct Unit { int pm, pn; };
struct ADesc { const char* base; size_t hstep; unsigned delta; };
struct StaticOrder {
    int nM, nN, nwg, G, c;
    __device__ void init(int nM_, int nN_, int G_, int c_) { nM = nM_; nN = nN_; nwg = nM * nN; G = G_; c = c_; }
    __device__ bool next(int i, Unit& u) const {
        const long L = (long)i * G + c; if (L >= nwg) return false;
        int wgid = (int)L; { const int q = nwg / NXCD, r = nwg % NXCD, xcd = wgid % NXCD, off = wgid / NXCD; wgid = (xcd < r ? xcd * (q + 1) : r * (q + 1) + (xcd - r) * q) + off; }
        const int nig = WGM * nN, gid = wgid / nig, fm = gid * WGM, gsz = (nM - fm) < WGM ? (nM - fm) : WGM;
        u.pm = fm + ((wgid % nig) % gsz); u.pn = (wgid % nig) / gsz; return true;
    }
};
template <class Epi, class AMap>
__device__ __forceinline__ void gemm_phase(ldsp lds, const bf16_t* Bt, int K, const StaticOrder& S, const AMap& AM, const Epi& E) {
    int tid_ = threadIdx.x; asm volatile("" : "+v"(tid_));
    const int tid = tid_, wid = __builtin_amdgcn_readfirstlane(tid >> 6), lane = tid & 63, wr = wid >> 2, wc = wid & 3, fr = lane & 15, fq = lane >> 4;
    const int nt = K / BK;
    unsigned voffA[2], voffB[2];
#pragma unroll
    for (int i = 0; i < 2; ++i) { int R, C; stage_rc(tid * 16 + i * 8192, R, C); const int Rb = (R & ~31) + perm32(R & 31);
        voffA[i] = (unsigned)(R * K + C) * 2u; voffB[i] = (unsigned)(Rb * K + C) * 2u; }
    const size_t kstep = (size_t)(BK * 2);
    const size_t hstepB = (size_t)HALF * K * 2;
    const size_t tstepB = 2 * hstepB;
    const unsigned ldsw = (unsigned)wid * 1024u;
    const int aoff = lds_byte(wr * 64 + fr, fq * 8), boff = lds_byte(wc * 32 + fr, fq * 8);
#define PG8_SA(b, h) (((b) * 2 + (h)) * HTB)
#define PG8_SB(b, h) ((4 + (b) * 2 + (h)) * HTB)
#define PG8_STAGEB(bufoff, gbase) do { _Pragma("unroll") for (int _i = 0; _i < 2; ++_i) \
        __builtin_amdgcn_global_load_lds((const unsigned*)((const char*)(gbase) + voffB[_i]), (LAS unsigned*)(lds + (bufoff) + ldsw + _i * 8192), 16, 0, 0); } while (0)
#define PG8_STAGEA(bufoff, gbase, dlt) do { _Pragma("unroll") for (int _i = 0; _i < 2; ++_i) \
        __builtin_amdgcn_global_load_lds((const unsigned*)((const char*)(gbase) + voffA[_i] - (size_t)(_i * (dlt))), (LAS unsigned*)(lds + (bufoff) + ldsw + _i * 8192), 16, 0, 0); } while (0)
#define PG8_LDA(dst, b, h) do { _Pragma("unroll") for (int m = 0; m < 4; ++m) _Pragma("unroll") for (int k = 0; k < 2; ++k) dst[m][k] = *(const LAS bf16x8*)(lds + PG8_SA(b, h) + aoff + m * 2048 + k * 1024); } while (0)
#define PG8_LDB(dst, b, h) do { _Pragma("unroll") for (int n = 0; n < 2; ++n) _Pragma("unroll") for (int k = 0; k < 2; ++k) dst[n][k] = *(const LAS bf16x8*)(lds + PG8_SB(b, h) + boff + n * 2048 + k * 1024); } while (0)
#define PG8_MMA(ai, bj, At, Bt_) do { __builtin_amdgcn_s_setprio(1); _Pragma("unroll") for (int m = 0; m < 4; ++m) _Pragma("unroll") for (int n = 0; n < 2; ++n) _Pragma("unroll") for (int k = 0; k < 2; ++k) \
        acc[ai][bj][m][n] = __builtin_amdgcn_mfma_f32_16x16x32_bf16(Bt_[n][k], At[m][k], acc[ai][bj][m][n], 0, 0, 0); __builtin_amdgcn_s_setprio(0); } while (0)
#define PG8_WAIT_V(n) asm volatile("s_waitcnt vmcnt(" #n ")" ::: "memory")
#define PG8_WAIT_L(n) asm volatile("s_waitcnt lgkmcnt(" #n ")" ::: "memory")
#define PG8_BAR __builtin_amdgcn_s_barrier()
#define PG8_SCHED __builtin_amdgcn_sched_barrier(0)
    Unit cur, nxt; int ui = 0;
    if (!S.next(0, cur)) return;
    f32x4 acc[2][2][4][2];
#pragma unroll
    for (int a = 0; a < 2; ++a)
#pragma unroll
        for (int b = 0; b < 2; ++b)
#pragma unroll
            for (int m = 0; m < 4; ++m)
#pragma unroll
                for (int n = 0; n < 2; ++n) acc[a][b][m][n] = (f32x4){0.f, 0.f, 0.f, 0.f};
    bf16x8 At[4][2], B0[2][2], B1[2][2];
    ADesc cd = AM(cur);
    const char* cA = cd.base; size_t cH = cd.hstep; unsigned cD = cd.delta;
    const char* cB = (const char*)Bt + (size_t)cur.pn * tstepB;
    PG8_STAGEB(PG8_SB(0, 0), cB); PG8_STAGEB(PG8_SB(0, 1), cB + hstepB); PG8_STAGEA(PG8_SA(0, 0), cA, cD); PG8_STAGEA(PG8_SA(0, 1), cA + cH, cD);
    if (wr == 1) PG8_BAR;
    PG8_WAIT_V(2); PG8_BAR;
    PG8_STAGEB(PG8_SB(1, 0), cB + kstep); PG8_STAGEA(PG8_SA(1, 0), cA + kstep, cD); PG8_STAGEB(PG8_SB(1, 1), cB + hstepB + kstep);
    PG8_WAIT_V(6); PG8_BAR;
    for (;;) {
        const bool has_next = S.next(ui + 1, nxt);
        ADesc nd = cd; if (has_next) nd = AM(nxt);
        const char* nA = nd.base; const size_t nH = nd.hstep; const unsigned nD = nd.delta;
        const char* nB = has_next ? (const char*)Bt + (size_t)nxt.pn * tstepB : cB;
        for (int t = 0; t < nt; t += 2) {
            const bool last = (t == nt - 2);
            const char* a1 = cA + (size_t)(t + 1) * kstep;
            const char* a2 = last ? nA : cA + (size_t)(t + 2) * kstep; const char* b2 = last ? nB : cB + (size_t)(t + 2) * kstep;
            const char* a3 = a2 + kstep; const char* b3 = b2 + kstep;
            const size_t h2 = last ? nH : cH; const unsigned d2 = last ? nD : cD;
            PG8_LDB(B0, 0, 0); PG8_LDB(B1, 0, 1); PG8_SCHED; PG8_LDA(At, 0, 0); PG8_STAGEA(PG8_SA(1, 1), a1 + cH, cD);
            PG8_WAIT_V(8); PG8_WAIT_L(0); PG8_BAR; PG8_MMA(0, 0, At, B0); PG8_MMA(0, 1, At, B1); PG8_BAR; PG8_SCHED;
            PG8_LDA(At, 0, 1); PG8_STAGEB(PG8_SB(0, 0), b2); PG8_STAGEB(PG8_SB(0, 1), b2 + hstepB); PG8_STAGEA(PG8_SA(0, 0), a2, d2);
            PG8_WAIT_V(8); PG8_WAIT_L(0); PG8_BAR; PG8_MMA(1, 0, At, B0); PG8_MMA(1, 1, At, B1); PG8_BAR; PG8_SCHED;
            PG8_LDB(B0, 1, 0); PG8_LDB(B1, 1, 1); PG8_SCHED; PG8_LDA(At, 1, 0); PG8_STAGEA(PG8_SA(0, 1), a2 + h2, d2);
            PG8_WAIT_V(8); PG8_WAIT_L(0); PG8_BAR; PG8_MMA(0, 0, At, B0); PG8_MMA(0, 1, At, B1); PG8_BAR; PG8_SCHED;
            PG8_LDA(At, 1, 1); PG8_STAGEB(PG8_SB(1, 0), b3); PG8_STAGEB(PG8_SB(1, 1), b3 + hstepB); PG8_STAGEA(PG8_SA(1, 0), a3, d2);
            PG8_WAIT_V(8); PG8_WAIT_L(0); PG8_BAR; PG8_MMA(1, 0, At, B0); PG8_MMA(1, 1, At, B1); PG8_BAR; PG8_SCHED;
        }
        if (wr == 0) PG8_BAR;
        E(acc, cur, wr, wc, fr, fq);
        if (!has_next) break;
#pragma unroll
        for (int a = 0; a < 2; ++a)
#pragma unroll
            for (int b = 0; b < 2; ++b)
#pragma unroll
                for (int m = 0; m < 4; ++m)
#pragma unroll
                    for (int n = 0; n < 2; ++n) acc[a][b][m][n] = (f32x4){0.f, 0.f, 0.f, 0.f};
        cur = nxt; cA = nA; cB = nB; cH = nH; cD = nD; cd = nd; ++ui;
        if (wr == 1) PG8_BAR;
    }
    PG8_WAIT_V(0);
    PG8_BAR;
#undef PG8_SA
#undef PG8_SB
#undef PG8_STAGEA
#undef PG8_STAGEB
#undef PG8_LDA
#undef PG8_LDB
#undef PG8_MMA
#undef PG8_WAIT_V
#undef PG8_WAIT_L
#undef PG8_BAR
#undef PG8_SCHED
}
}
using pg8::Unit; using pg8::ADesc;
typedef f32x4 Acc[2][2][4][2];

struct AMapStd { const char* A; size_t tstep, hstep; __device__ __forceinline__ ADesc operator()(const Unit& u) const { return ADesc{A + (size_t)u.pm * tstep, hstep, 0u}; } };
struct AMapUp {
    const char* A;
    __device__ __forceinline__ ADesc operator()(const Unit& u) const {
        if (u.pm < 68) return ADesc{A + (size_t)u.pm * 248 * DM * 2, (size_t)124 * DM * 2, 2u * DM * 2u};
        return ADesc{A + (size_t)X1B_SROW * DM * 2, (size_t)128 * DM * 2, 0u};
    }
};

struct Epi1 {
    bf16_t* proj; float* out;
    __device__ __forceinline__ void operator()(const Acc& acc, const Unit& u, int wr, int wc, int fr_, int fq_) const {
        int fr = fr_, fq = fq_; asm volatile("" : "+v"(fr), "+v"(fq));
        const int colb = u.pn * 256 + wc * 32 + 8 * fq;
#pragma unroll
        for (int ai = 0; ai < 2; ++ai)
#pragma unroll
            for (int m = 0; m < 4; ++m) {
                const int row = u.pm * 256 + ai * 128 + wr * 64 + m * 16 + fr;
                float* wrow = nullptr;
                if (u.pn >= 10) {
                    const bool isv = u.pn >= 12;
                    if (row < MP) { const int b = row >> 12, t = row & 4095; if (t >= SEQ - WINR) wrow = out + (isv ? O_WVP : O_WKP) + ((size_t)b * WINR + (t - (SEQ - WINR))) * 512; }
                    else { const int s = row - MP, b = s >> 3, i = s & 7; wrow = out + (isv ? O_WVS : O_WKS) + ((size_t)b * WINR + (WINR - STOK + i)) * 512; }
                }
#pragma unroll
                for (int bj = 0; bj < 2; ++bj) {
                    const f32x4 v0 = acc[ai][bj][m][0], v1 = acc[ai][bj][m][1];
                    const int col = colb + bj * 128;
                    u32x4 w; w.x = pk2(v0[0], v0[1]); w.y = pk2(v0[2], v0[3]); w.z = pk2(v1[0], v1[1]); w.w = pk2(v1[2], v1[3]);
                    *(u32x4*)(proj + (size_t)row * DIN + col) = w;
                    if (wrow) { const int c = (col - C_AK) & 511; *(f32x4*)(wrow + c) = v0; *(f32x4*)(wrow + c + 4) = v1; }
                }
            }
    }
};
struct Epi5 {
    const float* xp; const float* xs; float* x1; bf16_t* x1b; float* rsq; int do_rsq;
    __device__ __forceinline__ void operator()(const Acc& acc, const Unit& u, int wr, int wc, int fr_, int fq_) const {
        int fr = fr_, fq = fq_; asm volatile("" : "+v"(fr), "+v"(fq));
        const int colb = u.pn * 256 + wc * 32 + 8 * fq;
#pragma unroll
        for (int ai = 0; ai < 2; ++ai)
#pragma unroll
            for (int m = 0; m < 4; ++m) {
                const int row = u.pm * 256 + ai * 128 + wr * 64 + m * 16 + fr;
                const float* xrow = row < MP ? xp + (size_t)row * DM : xs + (size_t)(row - MP) * DM;
                const int brow = row < MP ? (row >> 12) * X1B_PB + 2 + (row & 4095) : X1B_SROW + (row - MP);
                float ss = 0.f;
#pragma unroll
                for (int bj = 0; bj < 2; ++bj) {
                    const int col = colb + bj * 128;
                    const f32x4 v0 = acc[ai][bj][m][0] + *(const f32x4*)(xrow + col), v1 = acc[ai][bj][m][1] + *(const f32x4*)(xrow + col + 4);
                    u32x4 w; w.x = pk2(v0[0], v0[1]); w.y = pk2(v0[2], v0[3]); w.z = pk2(v1[0], v1[1]); w.w = pk2(v1[2], v1[3]);
                    *(u32x4*)(x1b + (size_t)brow * DM + col) = w;
                    ss += (v0[0] * v0[0] + v0[1] * v0[1]) + (v0[2] * v0[2] + v0[3] * v0[3]) + (v1[0] * v1[0] + v1[1] * v1[1]) + (v1[2] * v1[2] + v1[3] * v1[3]);
                }
                ss += __shfl_xor(ss, 16); ss += __shfl_xor(ss, 32);
                if (fq == 0 && do_rsq) unsafeAtomicAdd(rsq + row, ss);
            }
    }
};
struct Epi6 {
    const float* rsq; const float* cw; const float* cb; const float* sconv; bf16_t* g; float* out;
    __device__ __forceinline__ void operator()(const Acc& acc, const Unit& u, int wr, int wc, int fr_, int fq_) const {
        int fr = fr_, fq = fq_; asm volatile("" : "+v"(fr), "+v"(fq));
        const bool samp = (u.pm >= 68);
        const int pb = u.pm / 17, pi = u.pm - pb * 17;
        float rstd8[2][4];
#pragma unroll
        for (int ai = 0; ai < 2; ++ai)
#pragma unroll
            for (int m = 0; m < 4; ++m) {
                const int q = ai * 2 + wr, lr = m * 16 + fr; int tok;
                if (!samp) { const int p = pi * 248 + q * 62 + lr - 2; const int pc = p < 0 ? 0 : (p >= SEQ ? SEQ - 1 : p); tok = pb * SEQ + pc; }
                else tok = MP + q * 64 + lr;
                rstd8[ai][m] = rsq[tok];
            }
#pragma unroll
        for (int ai = 0; ai < 2; ++ai)
#pragma unroll
            for (int m = 0; m < 4; ++m) rstd8[ai][m] = __builtin_amdgcn_rsqf(rstd8[ai][m] * (1.0f / DM) + EPS);
        const int c0 = u.pn * 128 + wc * 32 + 8 * fq;
        f32x4 w0[2], w1[2], w2[2], bb[2];
#pragma unroll
        for (int n = 0; n < 2; ++n) { w0[n] = *(const f32x4*)(cw + c0 + 4 * n); w1[n] = *(const f32x4*)(cw + DFF + c0 + 4 * n); w2[n] = *(const f32x4*)(cw + 2 * DFF + c0 + 4 * n); bb[n] = *(const f32x4*)(cb + c0 + 4 * n); }
#pragma unroll
        for (int ai = 0; ai < 2; ++ai) {
            const int q = ai * 2 + wr;
            f32x4 pr1[2], pr2[2];
#pragma unroll
            for (int n = 0; n < 2; ++n) { pr1[n] = (f32x4){0.f, 0.f, 0.f, 0.f}; pr2[n] = (f32x4){0.f, 0.f, 0.f, 0.f}; }
#pragma unroll
            for (int m = 0; m < 4; ++m) {
                const int lr = m * 16 + fr;
                int tok, p = 0, sb = 0, stt = 0; bool valid;
                if (!samp) { p = pi * 248 + q * 62 + lr - 2; valid = (lr >= 2) && (p < SEQ); const int pc = p < 0 ? 0 : (p >= SEQ ? SEQ - 1 : p); tok = pb * SEQ + pc; }
                else { const int s = q * 64 + lr; sb = s >> 3; stt = s & 7; tok = MP + s; valid = true; }
                const float rstd = rstd8[ai][m];
                u32x4 wout; f32x4 uas[2];
#pragma unroll
                for (int n = 0; n < 2; ++n) {
                    const f32x4 ua = acc[ai][0][m][n] * rstd, ub = acc[ai][1][m][n] * rstd;
                    f32x4 r1, r2, o, p1, p2;
#pragma unroll
                    for (int e = 0; e < 4; ++e) { const float uae = ua[e]; const int uai = __float_as_int(uae);
                        r1[e] = __int_as_float(__builtin_amdgcn_update_dpp(0, uai, 0x121, 0xf, 0xf, false));
                        r2[e] = __int_as_float(__builtin_amdgcn_update_dpp(0, uai, 0x122, 0xf, 0xf, false)); }
                    if (!samp) {
#pragma unroll
                        for (int e = 0; e < 4; ++e) { p1[e] = fr >= 1 ? r1[e] : pr1[n][e]; p2[e] = fr >= 2 ? r2[e] : pr2[n][e]; }
                    } else {
                        const float* s0 = sconv + (size_t)sb * 2 * DFF + c0 + 4 * n;
                        const f32x4 sa = *(const f32x4*)s0, sbv = *(const f32x4*)(s0 + DFF);
#pragma unroll
                        for (int e = 0; e < 4; ++e) { p1[e] = stt >= 1 ? r1[e] : sbv[e]; p2[e] = stt >= 2 ? r2[e] : (stt == 1 ? sbv[e] : sa[e]); }
                    }
#pragma unroll
                    for (int e = 0; e < 4; ++e) { const float cv = bb[n][e] + w0[n][e] * p2[e] + w1[n][e] * p1[e] + w2[n][e] * ua[e]; o[e] = silu(cv) * ub[e]; }
                    pr1[n] = r1; pr2[n] = r2; uas[n] = ua;
                    if (n == 0) { wout.x = pk2(o[0], o[1]); wout.y = pk2(o[2], o[3]); } else { wout.z = pk2(o[0], o[1]); wout.w = pk2(o[2], o[3]); }
                }
                if (valid) {
                    *(u32x4*)(g + (size_t)tok * DFF + c0) = wout;
                    float* so = nullptr;
                    if (!samp) { if (p >= SEQ - 2) so = out + O_CVP + ((size_t)pb * 2 + (p - (SEQ - 2))) * DFF + c0; }
                    else { if (stt >= 6) so = out + O_CVS + ((size_t)sb * 2 + (stt - 6)) * DFF + c0; }
                    if (so) { *(f32x4*)so = uas[0]; *(f32x4*)(so + 4) = uas[1]; }
                }
            }
        }
    }
};
struct Args;
__device__ __forceinline__ void cache_copy(const Args& a, int lo, int hi, int worker, int nw, int tid);
struct Epi7 {
    const bf16_t* x1b; float* y; float* rsq2; unsigned* cnt; const float* wf; const Args* args; int copy_worker, copy_nw, copy_lo, copy_hi;
    __device__ __forceinline__ void operator()(Acc& acc, const Unit& u, int wr, int wc, int fr_, int fq_) const {
        int fr = fr_, fq = fq_; asm volatile("" : "+v"(fr), "+v"(fq));
        const int colb = u.pn * 256 + wc * 32 + 8 * fq;
#pragma unroll
        for (int ai = 0; ai < 2; ++ai)
#pragma unroll
            for (int m = 0; m < 4; ++m) {
                const int row = u.pm * 256 + ai * 128 + wr * 64 + m * 16 + fr;
                const int brow = row < MP ? (row >> 12) * X1B_PB + 2 + (row & 4095) : X1B_SROW + (row - MP);
                float ss = 0.f;
#pragma unroll
                for (int bj = 0; bj < 2; ++bj) {
                    const int col = colb + bj * 128;
                    const u32x4 r = *(const u32x4*)(x1b + (size_t)brow * DM + col);
                    const f32x4 r0 = {__uint_as_float(r.x << 16), __uint_as_float(r.x & 0xffff0000u), __uint_as_float(r.y << 16), __uint_as_float(r.y & 0xffff0000u)};
                    const f32x4 r1 = {__uint_as_float(r.z << 16), __uint_as_float(r.z & 0xffff0000u), __uint_as_float(r.w << 16), __uint_as_float(r.w & 0xffff0000u)};
                    const f32x4 v0 = acc[ai][bj][m][0] + r0, v1 = acc[ai][bj][m][1] + r1;
                    acc[ai][bj][m][0] = v0; acc[ai][bj][m][1] = v1;
                    ss += (v0[0] * v0[0] + v0[1] * v0[1]) + (v0[2] * v0[2] + v0[3] * v0[3]) + (v1[0] * v1[0] + v1[1] * v1[1]) + (v1[2] * v1[2] + v1[3] * v1[3]);
                }
                ss += __shfl_xor(ss, 16); ss += __shfl_xor(ss, 32);
                if (fq == 0) unsafeAtomicAdd(rsq2 + row, ss);
            }
        asm volatile("s_waitcnt vmcnt(0)" ::: "memory");
        unsigned* pc = cnt + 64 * u.pm;
        if ((threadIdx.x & 63) == 0) __hip_atomic_fetch_add(pc, 1u, __ATOMIC_RELAXED, __HIP_MEMORY_SCOPE_AGENT);
        if (copy_nw > 0) cache_copy(*args, copy_lo, copy_hi, copy_worker, copy_nw, threadIdx.x);
        {
            unsigned sp = 0;
            while (__hip_atomic_load(pc, __ATOMIC_RELAXED, __HIP_MEMORY_SCOPE_AGENT) < 32u) { __builtin_amdgcn_s_sleep(4); if (++sp > (1u << 22)) break; }
            asm volatile("" ::: "memory");
        }
        f32x4 wv[2][2];
#pragma unroll
        for (int bj = 0; bj < 2; ++bj) { wv[bj][0] = *(const f32x4*)(wf + colb + bj * 128); wv[bj][1] = *(const f32x4*)(wf + colb + bj * 128 + 4); }
#pragma unroll
        for (int ai = 0; ai < 2; ++ai)
#pragma unroll
            for (int m = 0; m < 4; ++m) {
                const int row = u.pm * 256 + ai * 128 + wr * 64 + m * 16 + fr;
                const float rstd = __builtin_amdgcn_rsqf(__hip_atomic_load(rsq2 + row, __ATOMIC_RELAXED, __HIP_MEMORY_SCOPE_AGENT) * (1.0f / DM) + EPS);
                const size_t ro = (size_t)row * DM;
#pragma unroll
                for (int bj = 0; bj < 2; ++bj) {
                    const int col = colb + bj * 128;
                    *(f32x4*)(y + ro + col) = acc[ai][bj][m][0] * rstd * wv[bj][0];
                    *(f32x4*)(y + ro + col + 4) = acc[ai][bj][m][1] * rstd * wv[bj][1];
                }
            }
    }
};

#define XB_TMO      128
#define XB_XCNT(j)  (256  + 64 * (j))
#define XB_XSUB(j)  (1280 + 64 * (j))
#define XB_XGEN(j)  (2304 + 64 * (j))
#define XB_TOP      3328
#define XB_TOPGEN   3392
#define XCD_BAR_WORDS 3456
#define XB_SPIN_CAP (1u << 20)
__device__ __forceinline__ unsigned xb_ld(unsigned* p)              { return __hip_atomic_load(p, __ATOMIC_RELAXED, __HIP_MEMORY_SCOPE_AGENT); }
__device__ __forceinline__ unsigned xb_add(unsigned* p, unsigned v) { return __hip_atomic_fetch_add(p, v, __ATOMIC_RELAXED, __HIP_MEMORY_SCOPE_AGENT); }
__device__ __forceinline__ unsigned xb_xcc_id() { return (unsigned)__builtin_amdgcn_s_getreg((3 << 11) | 20) & 0xFu; }
#define XB_SPIN(cond, bar) do { unsigned _sp = 0; while (cond) { __builtin_amdgcn_s_sleep(1); \
    if ((++_sp & 255u) == 0u) { if (xb_ld(&(bar)[XB_TMO])) break; if (_sp > XB_SPIN_CAP) { atomicAdd(&(bar)[XB_TMO], 1u); break; } } } } while (0)
struct XcdBarrier { unsigned* bar; unsigned x; volatile LAS unsigned* st; };
__device__ __forceinline__ XcdBarrier xcd_barrier_post(unsigned* bar, volatile LAS unsigned* st) {
    XcdBarrier b; b.bar = bar; b.x = xb_xcc_id(); b.st = st;
    if (threadIdx.x == 0) (void)xb_add(&bar[XB_XCNT(b.x)], 1u);
    return b;
}
__device__ __forceinline__ void xcd_barrier_complete(unsigned* bar, unsigned x, unsigned& nloc, unsigned& nx) {
    const unsigned G = gridDim.x * gridDim.y * gridDim.z;
    unsigned sum, cnt, mine, sp = 0u;
    for (;;) {
        sum = 0u; cnt = 0u; mine = 0u;
#pragma unroll
        for (unsigned j = 0; j < 16; ++j) { const unsigned c = xb_ld(&bar[XB_XCNT(j)]); sum += c; cnt += (c > 0u) ? 1u : 0u; mine = (j == x) ? c : mine; }
        if (sum == G) break;
        __builtin_amdgcn_s_sleep(1);
        if ((++sp & 255u) == 0u) { if (xb_ld(&bar[XB_TMO])) break; if (sp > XB_SPIN_CAP) { atomicAdd(&bar[XB_TMO], 1u); break; } }
    }
    nloc = mine > 0u ? mine : 1u; nx = cnt > 0u ? cnt : 1u;
}
__device__ __forceinline__ void xcd_barrier(const XcdBarrier& b) {
    asm volatile("s_waitcnt vmcnt(0)" ::: "memory");
    __syncthreads();
    if (threadIdx.x == 0) {
        unsigned* bar = b.bar;
        __builtin_amdgcn_s_waitcnt(0);
        unsigned nloc = b.st[0], nx = b.st[1];
        if (nloc == 0u) { xcd_barrier_complete(bar, b.x, nloc, nx); b.st[0] = nloc; b.st[1] = nx; }
        const unsigned old = xb_add(&bar[XB_XSUB(b.x)], 1u);
        const unsigned gen = old / nloc;
        if (old + 1u == (gen + 1u) * nloc) {
            __builtin_amdgcn_fence(__ATOMIC_RELEASE, "agent");
            asm volatile("s_waitcnt vmcnt(0)" ::: "memory");
            const unsigned og = xb_add(&bar[XB_TOP], 1u);
            const unsigned tg = og / nx;
            if (og + 1u == (tg + 1u) * nx) xb_add(&bar[XB_TOPGEN], 1u);
            else XB_SPIN(xb_ld(&bar[XB_TOPGEN]) == tg, bar);
            __builtin_amdgcn_fence(__ATOMIC_ACQUIRE, "agent");
            xb_add(&bar[XB_XGEN(b.x)], 1u);
            asm volatile("s_waitcnt vmcnt(0)" ::: "memory");
        } else {
            XB_SPIN(xb_ld(&bar[XB_XGEN(b.x)]) == gen, bar);
            __builtin_amdgcn_fence(__ATOMIC_ACQUIRE, "agent");
            asm volatile("s_waitcnt vmcnt(0)" ::: "memory");
        }
    }
    __syncthreads();
}

struct Args { const float* in[17]; float* out; unsigned char* ws; };

__device__ __forceinline__ void p0_transpose_item(const float* W, int K, int N, bf16_t* WT, int k0, int n0, int drow0, const float* kscale, LAS float* scr, int lane) {
#pragma unroll 8
    for (int i = 0; i < 32; ++i) { const int kk = 2 * i + (lane >> 5); float v = W[(size_t)(k0 + kk) * N + n0 + (lane & 31)]; if (kscale) v *= kscale[k0 + kk]; scr[kk * 33 + (lane & 31)] = v; }
    asm volatile("s_waitcnt lgkmcnt(0)" ::: "memory");
    const int c = lane & 7;
#pragma unroll
    for (int j = 0; j < 4; ++j) { const int n = (lane >> 3) + 8 * j; const LAS float* s = scr + (8 * c) * 33 + n;
        u32x4 o; o.x = pk2(s[0 * 33], s[1 * 33]); o.y = pk2(s[2 * 33], s[3 * 33]); o.z = pk2(s[4 * 33], s[5 * 33]); o.w = pk2(s[6 * 33], s[7 * 33]);
        *(u32x4*)(WT + (size_t)(drow0 + n) * K + k0 + 8 * c) = o; }
    asm volatile("s_waitcnt lgkmcnt(0)" ::: "memory");
}

__device__ __forceinline__ float lgam(int h) { return __logf(1.f - ex2(-5.f - (float)h)) * LOG2E; }

__device__ __forceinline__ void ret_local_item(ldsp lds, const bf16_t* proj, float* U, int item, int tid) {
    const int lane = tid & 63, wave = tid >> 6, fr = lane & 15, g = lane >> 4;
    const int bh = item >> 5, c = item & 31, b = bh >> 3, h = bh & 7;
    const float l2g = lgam(h);
    constexpr int RS = 144;
    ldsp KT = lds, VT = lds + 128 * RS;
    const size_t tok0 = (size_t)b * SEQ + c * 128;
    __syncthreads();
#pragma unroll
    for (int u = 0; u < 2; ++u) {
        const int idx = u * 512 + tid, j = idx >> 3, ch = idx & 7;
        const bf16_t* src = proj + (tok0 + j) * DIN + h * 64 + ch * 8;
        const u32x4 kv = *(const u32x4*)(src + C_RK), vv = *(const u32x4*)(src + C_RV);
        const float dec = 0.125f * ex2(l2g * (float)(127 - j));
        u32x4 kd;
#pragma unroll
        for (int e = 0; e < 4; ++e) { const unsigned kw = kv[e]; kd[e] = pk2(__uint_as_float(kw << 16) * dec, __uint_as_float(kw & 0xffff0000u) * dec); }
        *(LAS u32x4*)(KT + j * RS + ch * 16) = kd; *(LAS u32x4*)(VT + j * RS + ch * 16) = vv;
    }
    __syncthreads();
    float* Uo = U + (size_t)item * 4096;
#pragma unroll
    for (int t = 0; t < 2; ++t) {
        const int tile = wave * 2 + t, ti = tile >> 2, tj = tile & 3;
        f32x4 acc = {0.f, 0.f, 0.f, 0.f};
#pragma unroll
        for (int ks = 0; ks < 4; ++ks) {
            const bf16x8 a = tr_frag(KT, RS, ks * 32 + g * 8, ks * 32 + g * 8 + 4, ti * 16, fr);
            const bf16x8 bb = tr_frag(VT, RS, ks * 32 + g * 8, ks * 32 + g * 8 + 4, tj * 16, fr);
            acc = MFMA16(a, bb, acc);
        }
#pragma unroll
        for (int jj = 0; jj < 4; ++jj) Uo[(ti * 16 + 4 * g + jj) * 64 + tj * 16 + fr] = acc[jj];
    }
}

struct AttnRegs { u32x4 qv[2], kv[4], vv[4]; };
struct AttnItem { int b, h, br, d, r, i0; };
__device__ __forceinline__ AttnItem attn_decode(int item) {
    AttnItem t; const int bh = item / 96, rem = item - bh * 96, ci = rem & 31; t.br = rem >> 5; t.b = bh >> 3; t.h = bh & 7;
    const int dsh = 2 * t.br, cps = 32 >> dsh; t.d = 1 << dsh; t.r = ci / cps; t.i0 = (ci - t.r * cps) * 128; return t;
}
__device__ __forceinline__ void attn_load(AttnRegs& R, const bf16_t* proj, int item, int tid, bool need_lower) {
    const AttnItem t = attn_decode(item);
    const size_t tb = (size_t)t.b * SEQ + t.r; const int d = t.d, i0 = t.i0, h = t.h;
#pragma unroll
    for (int u = 0; u < 2; ++u) { const int idx = u * 512 + tid, row = idx >> 3, ch = idx & 7;
        R.qv[u] = *(const u32x4*)(proj + (tb + (size_t)(i0 + row) * d) * DIN + C_AQ + h * 64 + ch * 8); }
#pragma unroll
    for (int u = 0; u < 2; ++u) { const int idx = u * 512 + tid, row = idx >> 3, ch = idx & 7;
        const bf16_t* src = proj + (tb + (size_t)(i0 + row) * d) * DIN + h * 64 + ch * 8;
        R.kv[u] = *(const u32x4*)(src + C_AK); R.vv[u] = *(const u32x4*)(src + C_AV); }
    if (need_lower) {
#pragma unroll
        for (int u = 0; u < 2; ++u) { const int idx = u * 512 + tid, row = idx >> 3, ch = idx & 7;
            const bf16_t* src = proj + (tb + (size_t)(i0 - 128 + row) * d) * DIN + h * 64 + ch * 8;
            R.kv[2 + u] = *(const u32x4*)(src + C_AK); R.vv[2 + u] = *(const u32x4*)(src + C_AV); }
    }
}
constexpr int AT_QS = 144, AT_VS = 528;
__device__ __forceinline__ void attn_store(ldsp lds, const AttnRegs& R, int tid, int parity, bool need_lower) {
    ldsp Qs = lds, Ks = lds + 128 * AT_QS, VT = Ks + 256 * AT_QS;
    const int up = parity * 128, lo = (1 - parity) * 128;
#pragma unroll
    for (int u = 0; u < 2; ++u) { const int idx = u * 512 + tid, row = idx >> 3, ch = idx & 7;
        *(LAS u32x4*)(Qs + row * AT_QS + ch * 16) = R.qv[u];
        *(LAS u32x4*)(Ks + (up + row) * AT_QS + ch * 16) = R.kv[u]; *(LAS u32x4*)(VT + (up + row) * AT_QS + ch * 16) = R.vv[u]; }
    if (need_lower) {
#pragma unroll
        for (int u = 0; u < 2; ++u) { const int idx = u * 512 + tid, row = idx >> 3, ch = idx & 7;
            *(LAS u32x4*)(Ks + (lo + row) * AT_QS + ch * 16) = R.kv[2 + u]; *(LAS u32x4*)(VT + (lo + row) * AT_QS + ch * 16) = R.vv[2 + u]; }
    }
}
__device__ __forceinline__ void attn_compute(ldsp lds, bf16_t* atto, float* attml, int item, int tid, int parity) {
    constexpr int QS = AT_QS, VS = AT_VS;
    const int lane = tid & 63, wave = __builtin_amdgcn_readfirstlane(tid >> 6), fr = lane & 15, g = lane >> 4;
    const AttnItem t = attn_decode(item);
    const int d = t.d, i0 = t.i0, h = t.h, br = t.br;
    const size_t tb = (size_t)t.b * SEQ + t.r;
    const bool first = (i0 == 0);
    ldsp Qs = lds, Ks = lds + 128 * QS, VT = Ks + 256 * QS;
    const int qi0 = wave * 16, qi = qi0 + fr;
    const bf16x8 bq0 = *(const LAS bf16x8*)(Qs + qi * QS + g * 16), bq1 = *(const LAS bf16x8*)(Qs + qi * QS + 64 + g * 16);
    const float slope = ex2(-(float)(h + 1));
    const float sc = 0.125f * LOG2E, sl = slope * (float)d * LOG2E;
    float mrun = -1e30f, lsum = 0.f;
    f32x4 ot[4];
#pragma unroll
    for (int et = 0; et < 4; ++et) ot[et] = (f32x4){0.f, 0.f, 0.f, 0.f};
    int kt_lo = qi0 >> 5; if (first && kt_lo < 4) kt_lo = 4;
    const int kt_hi = (qi0 + 15 + 128) >> 5;
#define AT_KB(kt) (((((kt) >> 2) ^ parity ^ 1) & 1) << 7 | (((kt) & 3) << 5))
    bf16x8 kf[2][2][2];
    {
        const int k1 = (kt_lo + 1 <= kt_hi) ? kt_lo + 1 : kt_lo; const int kb0 = AT_KB(kt_lo), kb1 = AT_KB(k1);
#pragma unroll
        for (int hf = 0; hf < 2; ++hf) {
            ldsp kp0 = Ks + (kb0 + hf * 16 + fr) * QS + g * 16; ldsp kp1 = Ks + (kb1 + hf * 16 + fr) * QS + g * 16;
            kf[0][hf][0] = *(const LAS bf16x8*)kp0; kf[0][hf][1] = *(const LAS bf16x8*)(kp0 + 64);
            kf[1][hf][0] = *(const LAS bf16x8*)kp1; kf[1][hf][1] = *(const LAS bf16x8*)(kp1 + 64);
        }
    }
    for (int kt0 = kt_lo; kt0 <= kt_hi; kt0 += 2) {
        const bool two = (kt0 + 1 <= kt_hi);
        const int ktv[2] = {kt0, two ? kt0 + 1 : kt0};
        int kbv[2];
#pragma unroll
        for (int tt = 0; tt < 2; ++tt) kbv[tt] = AT_KB(ktv[tt]);
        f32x4 st[4];
#pragma unroll
        for (int tt = 0; tt < 2; ++tt)
#pragma unroll
            for (int hf = 0; hf < 2; ++hf) {
                st[tt * 2 + hf] = MFMA16(kf[tt][hf][0], bq0, ((f32x4){0.f, 0.f, 0.f, 0.f}));
                st[tt * 2 + hf] = MFMA16(kf[tt][hf][1], bq1, st[tt * 2 + hf]);
            }
        bf16x8 vf[2][4];
#pragma unroll
        for (int tt = 0; tt < 2; ++tt)
#pragma unroll
            for (int et = 0; et < 4; ++et) vf[tt][et] = tr_frag(VT, QS, kbv[tt] + 4 * g, kbv[tt] + 16 + 4 * g, et * 16, fr);
        {
            const int n0 = (kt0 + 2 <= kt_hi) ? kt0 + 2 : kt_hi, n1 = (kt0 + 3 <= kt_hi) ? kt0 + 3 : kt_hi; const int kb0 = AT_KB(n0), kb1 = AT_KB(n1);
#pragma unroll
            for (int hf = 0; hf < 2; ++hf) {
                ldsp kp0 = Ks + (kb0 + hf * 16 + fr) * QS + g * 16; ldsp kp1 = Ks + (kb1 + hf * 16 + fr) * QS + g * 16;
                kf[0][hf][0] = *(const LAS bf16x8*)kp0; kf[0][hf][1] = *(const LAS bf16x8*)(kp0 + 64);
                kf[1][hf][0] = *(const LAS bf16x8*)kp1; kf[1][hf][1] = *(const LAS bf16x8*)(kp1 + 64);
            }
        }
        float s[16]; float tmax = -INFINITY;
#pragma unroll
        for (int tt = 0; tt < 2; ++tt)
#pragma unroll
            for (int hf = 0; hf < 2; ++hf)
#pragma unroll
                for (int jj = 0; jj < 4; ++jj) {
                    const int kj = ktv[tt] * 32 + hf * 16 + 4 * g + jj, dist = qi + 128 - kj;
                    const bool ok = ((unsigned)dist <= 128u) && (tt == 0 || two);
                    const float v = ok ? st[tt * 2 + hf][jj] * sc - sl * (float)dist : -INFINITY;
                    s[tt * 8 + hf * 4 + jj] = v; tmax = fmaxf(tmax, v);
                }
        tmax = fmaxf(tmax, __shfl_xor(tmax, 16)); tmax = fmaxf(tmax, __shfl_xor(tmax, 32));
        const float mnew = fmaxf(mrun, tmax), alpha = ex2(mrun - mnew); mrun = mnew;
        float ps = 0.f;
#pragma unroll
        for (int e = 0; e < 16; ++e) { s[e] = ex2(s[e] - mnew); ps += s[e]; }
        lsum = lsum * alpha + ps;
#pragma unroll
        for (int et = 0; et < 4; ++et) ot[et] = ot[et] * alpha;
#pragma unroll
        for (int tt = 0; tt < 2; ++tt) {
            u32x4 pw; pw.x = pk2(s[tt * 8 + 0], s[tt * 8 + 1]); pw.y = pk2(s[tt * 8 + 2], s[tt * 8 + 3]); pw.z = pk2(s[tt * 8 + 4], s[tt * 8 + 5]); pw.w = pk2(s[tt * 8 + 6], s[tt * 8 + 7]);
            const bf16x8 pf = __builtin_bit_cast(bf16x8, pw);
#pragma unroll
            for (int et = 0; et < 4; ++et) ot[et] = MFMA16(vf[tt][et], pf, ot[et]);
        }
    }
#undef AT_KB
    lsum += __shfl_xor(lsum, 16); lsum += __shfl_xor(lsum, 32);
    const float inv = __builtin_amdgcn_rcpf(lsum);
    const size_t tok = tb + (size_t)(i0 + qi) * d;
    bf16_t* od = atto + ((size_t)br * MP + tok) * 512 + h * 64;
#pragma unroll
    for (int et = 0; et < 4; ++et) { u32x2 w; w.x = pk2(ot[et][0] * inv, ot[et][1] * inv); w.y = pk2(ot[et][2] * inv, ot[et][3] * inv);
        *(u32x2*)(od + et * 16 + 4 * g) = w; }
    if (g == 0) { f32x2 ml = {mrun, lsum}; *(f32x2*)(attml + (((size_t)br * MP + tok) * 8 + h) * 2) = ml; }
}

__device__ __forceinline__ void sample_item(ldsp lds, const Args& a, const bf16_t* proj, bf16_t* mix, int item, int tid) {
    const int lane = tid & 63, wave = tid >> 6, b = item >> 3, h = item & 7;
    LAS float* qs = (LAS float*)lds;
    LAS float* ks = qs + 512;
    LAS float* vs = ks + 512;
    LAS float* aq = vs + 512;
    LAS float* sc = aq + 512;
    LAS float* part = sc + 64;
    LAS float* pbuf = part + 4096;
    const float l2g = lgam(h);
    __syncthreads();
    {
        const int i = tid >> 6, e = tid & 63;
        const bf16_t* src = proj + (size_t)(MP + b * 8 + i) * DIN + h * 64 + e;
        qs[tid] = bf2f(src[C_RQ]); ks[tid] = bf2f(src[C_RK]) * 0.125f; vs[tid] = bf2f(src[C_RV]); aq[tid] = bf2f(src[C_AQ]) * 0.125f;
    }
    __syncthreads();
    if (tid < 64) { const int i = tid >> 3, j = tid & 7; float s = 0.f;
        if (j <= i) {
#pragma unroll 4
            for (int dd = 0; dd < 64; ++dd) s += qs[i * 64 + dd] * ks[j * 64 + dd];
            s *= ex2(l2g * (float)(i - j)); }
        sc[tid] = s; }
    {
        const int e = tid & 63, dkg = tid >> 6;
        const float* S0 = a.in[2] + ((size_t)(b * 8 + h) * 64 + dkg * 8) * 64 + e;
        float* So = a.out + O_RETS + ((size_t)(b * 8 + h) * 64 + dkg * 8) * 64 + e;
        float cr[8];
#pragma unroll
        for (int i = 0; i < 8; ++i) cr[i] = 0.f;
        const float g8 = ex2(l2g * 8.f);
        float vd[8];
#pragma unroll
        for (int i = 0; i < 8; ++i) vd[i] = ex2(l2g * (float)(7 - i)) * vs[i * 64 + e];
        float s0v[8];
#pragma unroll
        for (int k = 0; k < 8; ++k) s0v[k] = S0[k * 64];
#pragma unroll
        for (int k = 0; k < 8; ++k) {
            const int dk = dkg * 8 + k; const float s0 = s0v[k];
            float sn = s0 * g8;
#pragma unroll
            for (int i = 0; i < 8; ++i) { cr[i] += qs[i * 64 + dk] * s0; sn += ks[i * 64 + dk] * vd[i]; }
            So[k * 64] = sn;
        }
#pragma unroll
        for (int i = 0; i < 8; ++i) part[(dkg * 8 + i) * 64 + e] = cr[i];
    }
    __syncthreads();
    {
        const int i = wave, e = lane; float o = 0.f;
#pragma unroll
        for (int dkg = 0; dkg < 8; ++dkg) o += part[(dkg * 8 + i) * 64 + e];
        o *= ex2(l2g * (float)(i + 1));
        for (int j = 0; j <= i; ++j) o += sc[i * 8 + j] * vs[j * 64 + e];
        const float mu = wave_sum(o) * (1.f / 64.f), dv = o - mu, var = wave_sum(dv * dv) * (1.f / 64.f);
        const float nrm = dv * __builtin_amdgcn_rsqf(var + EPS) * a.in[8][h * 64 + e] + a.in[9][h * 64 + e];
        const size_t tok = (size_t)MP + b * 8 + i;
        const float gate = bf2f(proj[tok * DIN + C_RG + h * 64 + e]);
        mix[tok * DM + h * 64 + e] = f2bf(silu(gate) * nrm);
    }
    {
        const int i = wave, kg = lane >> 4, dc = lane & 15;
        const float* ck = a.in[3] + (size_t)b * WINR * 512 + h * 64 + 4 * dc; const float* cvp = a.in[4] + (size_t)b * WINR * 512 + h * 64 + 4 * dc;
        const float* nk = a.out + O_WKS + ((size_t)b * WINR + (WINR - STOK)) * 512 + h * 64 + 4 * dc; const float* nv = a.out + O_WVS + ((size_t)b * WINR + (WINR - STOK)) * 512 + h * 64 + 4 * dc;
        const float slope = ex2(-(float)(h + 1));
        LAS float* pw = pbuf + wave * 448;
        const f32x4 q4 = *(const LAS f32x4*)(aq + i * 64 + 4 * dc);
#pragma unroll 1
        for (int it0 = 0; it0 < 99; it0 += 33)
#pragma unroll
        for (int iu = 0; iu < 33; ++iu) {
            const int idx = (it0 + iu) * 4 + kg, idc = idx < 387 ? idx : 386;
            const int br = idc >= 258 ? 2 : (idc >= 129 ? 1 : 0), n = idc - br * 129, dist = n << (2 * br), loc = WINR + i - dist;
            const float* kr = loc < WINR ? ck + (size_t)loc * 512 : nk + (size_t)(loc - WINR) * 512;
            const f32x4 kk = *(const f32x4*)kr;
            float dot = (kk[0] * q4[0] + kk[1] * q4[1]) + (kk[2] * q4[2] + kk[3] * q4[3]);
            dot += __int_as_float(__builtin_amdgcn_update_dpp(0, __float_as_int(dot), 0x128, 0xf, 0xf, false));
            dot += __int_as_float(__builtin_amdgcn_update_dpp(0, __float_as_int(dot), 0x124, 0xf, 0xf, false));
            dot += __int_as_float(__builtin_amdgcn_update_dpp(0, __float_as_int(dot), 0x122, 0xf, 0xf, false));
            dot += __int_as_float(__builtin_amdgcn_update_dpp(0, __float_as_int(dot), 0x121, 0xf, 0xf, false));
            if (dc == 0 && idx < 387) pw[idx] = (dot - slope * (float)dist) * LOG2E;
        }
        asm volatile("s_waitcnt lgkmcnt(0)" ::: "memory");
        float mx = -INFINITY;
        for (int u = 0; u < 7; ++u) { const int idx = u * 64 + lane; if (idx < 387) mx = fmaxf(mx, pw[idx]); }
        mx = wave_max(mx);
        float ssum = 0.f;
        for (int u = 0; u < 7; ++u) { const int idx = u * 64 + lane; if (idx < 387) { const float p = ex2(pw[idx] - mx); pw[idx] = p; ssum += p; } }
        ssum = wave_sum(ssum);
        asm volatile("s_waitcnt lgkmcnt(0)" ::: "memory");
        f32x4 o = {0.f, 0.f, 0.f, 0.f};
#pragma unroll 1
        for (int it0 = 0; it0 < 99; it0 += 33)
#pragma unroll
        for (int iu = 0; iu < 33; ++iu) {
            const int idx = (it0 + iu) * 4 + kg, idc = idx < 387 ? idx : 386;
            const int br = idc >= 258 ? 2 : (idc >= 129 ? 1 : 0), n = idc - br * 129, loc = WINR + i - (n << (2 * br));
            const float* vr = loc < WINR ? cvp + (size_t)loc * 512 : nv + (size_t)(loc - WINR) * 512;
            const float p = idx < 387 ? pw[idc] : 0.f;
            o = o + *(const f32x4*)vr * p;
        }
#pragma unroll
        for (int e = 0; e < 4; ++e) { o[e] += __shfl_xor(o[e], 16); o[e] += __shfl_xor(o[e], 32); }
        if (kg == 0) {
            const float inv = 1.f / ssum; const size_t tok = (size_t)MP + b * 8 + i;
            u32x2 w; w.x = pk2(o[0] * inv, o[1] * inv); w.y = pk2(o[2] * inv, o[3] * inv);
            *(u32x2*)(mix + tok * DM + 512 + h * 64 + 4 * dc) = w;
        }
    }
}

struct RetRegs { u32x4 q[2], k[2], v[2], s; };
__device__ __forceinline__ void ret_load(RetRegs& R, const bf16_t* proj, const bf16_t* sin, int item, int tid) {
    const int bh = item >> 5, c = item & 31, b = bh >> 3, h = bh & 7;
    const size_t tok0 = (size_t)b * SEQ + c * 128;
#pragma unroll
    for (int u = 0; u < 2; ++u) {
        const int idx = u * 512 + tid, row = idx >> 3, ch = idx & 7; const bf16_t* src = proj + (tok0 + row) * DIN + h * 64 + ch * 8;
        R.q[u] = *(const u32x4*)(src + C_RQ); R.k[u] = *(const u32x4*)(src + C_RK); R.v[u] = *(const u32x4*)(src + C_RV);
    }
    { const int dk = tid >> 3, ch = tid & 7; R.s = *(const u32x4*)(sin + (size_t)item * 4096 + dk * 64 + ch * 8); }
}
__device__ __forceinline__ void ret_store(ldsp lds, const RetRegs& R, int tid) {
    constexpr int QS = 144;
    ldsp Qs = lds, Ks = lds + 128 * QS, VT = Ks + 128 * QS, STt = VT + 128 * QS;
#pragma unroll
    for (int u = 0; u < 2; ++u) {
        const int idx = u * 512 + tid, row = idx >> 3, ch = idx & 7;
        *(LAS u32x4*)(Qs + row * QS + ch * 16) = R.q[u]; *(LAS u32x4*)(Ks + row * QS + ch * 16) = R.k[u]; *(LAS u32x4*)(VT + row * QS + ch * 16) = R.v[u];
    }
    { const int dk = tid >> 3, ch = tid & 7; *(LAS u32x4*)(STt + dk * QS + ch * 16) = R.s; }
}
__device__ __forceinline__ void ret_compute(ldsp lds, const Args& a, const bf16_t* proj, const bf16_t* atto, const float* attml, bf16_t* mix, int item, int tid) {
    const int lane = tid & 63, wave = __builtin_amdgcn_readfirstlane(tid >> 6), fr = lane & 15, g = lane >> 4;
    const int bh = item >> 5, c = item & 31, b = bh >> 3, h = bh & 7;
    const float l2g = lgam(h);
    constexpr int QS = 144;
    ldsp Qs = lds, Ks = lds + 128 * QS, VT = Ks + 128 * QS, STt = VT + 128 * QS;
    const size_t tok0 = (size_t)b * SEQ + c * 128;
    const int mt = tid >> 2, meg = (tid & 3) * 16; const size_t mtk = tok0 + mt;
    u32x2 rgw4[4];
#pragma unroll
    for (int et = 0; et < 4; ++et) rgw4[et] = *(const u32x2*)(proj + (tok0 + wave * 16 + fr) * DIN + C_RG + h * 64 + et * 16 + 4 * g);
    f32x2 mml[3]; u32x4 mv0[3], mv1[3];
#pragma unroll
    for (int br = 0; br < 3; ++br) { mml[br] = *(const f32x2*)(attml + (((size_t)br * MP + mtk) * 8 + h) * 2);
        const bf16_t* src = atto + ((size_t)br * MP + mtk) * 512 + h * 64 + meg; mv0[br] = *(const u32x4*)src; mv1[br] = *(const u32x4*)(src + 8); }
    const int qi0 = wave * 16, qi = qi0 + fr;
    const bf16x8 bq0 = *(const LAS bf16x8*)(Qs + qi * QS + g * 16), bq1 = *(const LAS bf16x8*)(Qs + qi * QS + 64 + g * 16);
    f32x4 ot[4], xs[4];
#pragma unroll
    for (int et = 0; et < 4; ++et) {
        ot[et] = (f32x4){0.f, 0.f, 0.f, 0.f};
        xs[et] = MFMA16(tr_frag(STt, QS, g * 8, g * 8 + 4, et * 16, fr), bq0, ((f32x4){0.f, 0.f, 0.f, 0.f}));
        xs[et] = MFMA16(tr_frag(STt, QS, 32 + g * 8, 32 + g * 8 + 4, et * 16, fr), bq1, xs[et]);
    }
    const int kt_hi = (qi0 + 15) >> 5;
    for (int kt = 0; kt <= kt_hi; ++kt) {
        f32x4 st[2];
#pragma unroll
        for (int hf = 0; hf < 2; ++hf) {
            ldsp kp = Ks + (kt * 32 + hf * 16 + fr) * QS + g * 16;
            st[hf] = MFMA16(*(const LAS bf16x8*)kp, bq0, ((f32x4){0.f, 0.f, 0.f, 0.f}));
            st[hf] = MFMA16(*(const LAS bf16x8*)(kp + 64), bq1, st[hf]);
        }
        float s[8];
#pragma unroll
        for (int hf = 0; hf < 2; ++hf)
#pragma unroll
            for (int jj = 0; jj < 4; ++jj) { const int dj = qi - (kt * 32 + hf * 16 + 4 * g + jj);
                s[hf * 4 + jj] = dj >= 0 ? st[hf][jj] * 0.125f * ex2(l2g * (float)dj) : 0.f; }
        u32x4 pw; pw.x = pk2(s[0], s[1]); pw.y = pk2(s[2], s[3]); pw.z = pk2(s[4], s[5]); pw.w = pk2(s[6], s[7]);
        const bf16x8 pf = __builtin_bit_cast(bf16x8, pw);
#pragma unroll
        for (int et = 0; et < 4; ++et) {
            ot[et] = MFMA16(tr_frag(VT, QS, kt * 32 + 4 * g, kt * 32 + 16 + 4 * g, et * 16, fr), pf, ot[et]);
        }
    }
    const float qdec = ex2(l2g * (float)(qi + 1));
    float sum = 0.f;
#pragma unroll
    for (int et = 0; et < 4; ++et) { ot[et] = ot[et] + xs[et] * qdec; sum += (ot[et][0] + ot[et][1]) + (ot[et][2] + ot[et][3]); }
    sum += __shfl_xor(sum, 16); sum += __shfl_xor(sum, 32);
    const float mu = sum * (1.f / 64.f); float vsum = 0.f;
#pragma unroll
    for (int et = 0; et < 4; ++et) { ot[et] = ot[et] - mu; vsum += (ot[et][0] * ot[et][0] + ot[et][1] * ot[et][1]) + (ot[et][2] * ot[et][2] + ot[et][3] * ot[et][3]); }
    vsum += __shfl_xor(vsum, 16); vsum += __shfl_xor(vsum, 32);
    const float rstd = __builtin_amdgcn_rsqf(vsum * (1.f / 64.f) + EPS);
    const size_t tok = tok0 + qi;
#pragma unroll
    for (int et = 0; et < 4; ++et) {
        const int ch = h * 64 + et * 16 + 4 * g;
        const f32x4 gw = *(const f32x4*)(a.in[8] + ch), gb = *(const f32x4*)(a.in[9] + ch);
        const u32x2 rgw = rgw4[et];
        const float g0 = __uint_as_float(rgw.x << 16), g1 = __uint_as_float(rgw.x & 0xffff0000u), g2 = __uint_as_float(rgw.y << 16), g3 = __uint_as_float(rgw.y & 0xffff0000u);
        u32x2 w;
        w.x = pk2(silu(g0) * (ot[et][0] * rstd * gw[0] + gb[0]), silu(g1) * (ot[et][1] * rstd * gw[1] + gb[1]));
        w.y = pk2(silu(g2) * (ot[et][2] * rstd * gw[2] + gb[2]), silu(g3) * (ot[et][3] * rstd * gw[3] + gb[3]));
        *(u32x2*)(mix + tok * DM + ch) = w;
    }
    {
        const int eg = meg; const size_t tk = mtk;
        float mm[3], ll[3], M = -INFINITY;
#pragma unroll
        for (int br = 0; br < 3; ++br) { mm[br] = mml[br].x; ll[br] = mml[br].y; M = fmaxf(M, mml[br].x); }
        float wsum = 0.f, wt[3];
#pragma unroll
        for (int br = 0; br < 3; ++br) { wt[br] = ll[br] * ex2(mm[br] - M); wsum += wt[br]; }
        const float winv = __builtin_amdgcn_rcpf(wsum);
        float o[16];
#pragma unroll
        for (int e = 0; e < 16; ++e) o[e] = 0.f;
#pragma unroll
        for (int br = 0; br < 3; ++br) {
            const float w = wt[br] * winv;
            const u32x4 v0 = mv0[br], v1 = mv1[br];
#pragma unroll
            for (int e = 0; e < 4; ++e) { o[2 * e] += w * __uint_as_float(v0[e] << 16); o[2 * e + 1] += w * __uint_as_float(v0[e] & 0xffff0000u);
                                          o[8 + 2 * e] += w * __uint_as_float(v1[e] << 16); o[8 + 2 * e + 1] += w * __uint_as_float(v1[e] & 0xffff0000u); }
        }
        u32x4 w0, w1; w0.x = pk2(o[0], o[1]); w0.y = pk2(o[2], o[3]); w0.z = pk2(o[4], o[5]); w0.w = pk2(o[6], o[7]);
        w1.x = pk2(o[8], o[9]); w1.y = pk2(o[10], o[11]); w1.z = pk2(o[12], o[13]); w1.w = pk2(o[14], o[15]);
        bf16_t* dst = mix + tk * DM + 512 + h * 64 + eg; *(u32x4*)dst = w0; *(u32x4*)(dst + 8) = w1;
    }
}

__device__ __forceinline__ void cache_copy(const Args& a, int lo, int hi, int worker, int nw, int tid) {
    constexpr int PB4 = (WINR - STOK) * 512 / 4;
    const f32x4* ck = (const f32x4*)a.in[3]; const f32x4* cv = (const f32x4*)a.in[4];
    f32x4* ok = (f32x4*)(a.out + O_WKS); f32x4* ov = (f32x4*)(a.out + O_WVS);
    for (int i0 = lo + worker * 2048 + tid; i0 < hi; i0 += nw * 2048) {
        f32x4 kk[4], vv[4]; size_t dd[4];
#pragma unroll
        for (int u = 0; u < 4; ++u) { int i = i0 + u * 512; if (i >= hi) i = hi - 1; const int b = i / PB4, j = i - b * PB4; dd[u] = (size_t)b * (WINR * 128) + j;
            kk[u] = __builtin_nontemporal_load(ck + dd[u] + STOK * 128); vv[u] = __builtin_nontemporal_load(cv + dd[u] + STOK * 128); }
#pragma unroll
        for (int u = 0; u < 4; ++u) { __builtin_nontemporal_store(kk[u], ok + dd[u]); __builtin_nontemporal_store(vv[u], ov + dd[u]); }
    }
}
constexpr int CC_TOT = SBAT * ((WINR - STOK) * 512 / 4), CC_1 = (22 * (CC_TOT / 100)) & ~2047, CC_2 = (40 * (CC_TOT / 100)) & ~2047;
constexpr int P1_COPY_BLOCKS = 28;

__global__ void __launch_bounds__(512, 2) fwd(Args a) {
    extern __shared__ __attribute__((aligned(16))) unsigned char lds_raw[];
    cg::grid_group grid = cg::this_grid();
    ldsp lds = (ldsp)lds_raw;
    const int G = gridDim.x, bx = blockIdx.x;
    volatile LAS unsigned* xbst = (volatile LAS unsigned*)(lds + LDS_BYTES - 16);
    if (threadIdx.x < 4) xbst[threadIdx.x] = 0u;
    __syncthreads();
    const XcdBarrier xbar = xcd_barrier_post((unsigned*)(a.ws + WS_BAR), xbst);
#define PHASE_IDS int tid = threadIdx.x; asm volatile("" : "+v"(tid)); const int lane = tid & 63, wave = __builtin_amdgcn_readfirstlane(tid >> 6); (void)lane; (void)wave;
    unsigned char* ws = a.ws;
    bf16_t* WinT = (bf16_t*)(ws + WS_WIN); bf16_t* WoutT = (bf16_t*)(ws + WS_WOUT); bf16_t* WupT = (bf16_t*)(ws + WS_WUP); bf16_t* WdnT = (bf16_t*)(ws + WS_WDN);
    float* RSQ = (float*)(ws + WS_RSQ); float* RSQ2 = (float*)(ws + WS_RSQ2); bf16_t* H1 = (bf16_t*)(ws + WS_H1); bf16_t* PROJ = (bf16_t*)(ws + WS_PROJ);
    float* U = (float*)(ws + WS_U); bf16_t* SIN = (bf16_t*)(ws + WS_SIN); bf16_t* ATTO = (bf16_t*)(ws + WS_ATTO); float* ATTML = (float*)(ws + WS_ATTML);
    bf16_t* MIX = (bf16_t*)(ws + WS_MIX); float* X1 = (float*)(ws + WS_X1); bf16_t* X1B = (bf16_t*)(ws + WS_X1B); bf16_t* GB = (bf16_t*)(ws + WS_G);

#if !defined(ONLY) || ONLY == 0
    REPS(0)
    {
        PHASE_IDS
        LAS float* scr = (LAS float*)(lds + wave * 16384);
        const int gw = bx * 8 + wave, NGW = G * 8;
        constexpr int I_IN = 16 * 112, I_OUT = 16 * 32, I_UP = 16 * 176, I_DN = 44 * 32, NIT = I_IN + I_OUT + I_UP + I_DN;
        for (int it = gw; it < NIT; it += NGW) {
            int r = it;
            if (r < I_IN) { const int kb = r / 112, nb = r - kb * 112; p0_transpose_item(a.in[7], DM, DIN, WinT, kb * 64, nb * 32, nb * 32, nullptr, scr, lane); continue; } r -= I_IN;
            if (r < I_OUT) { const int kb = r >> 5, nb = r & 31; p0_transpose_item(a.in[10], DM, DM, WoutT, kb * 64, nb * 32, nb * 32, nullptr, scr, lane); continue; } r -= I_OUT;
            if (r < I_UP) { const int kb = r / 176, nb = r - kb * 176; const int n0 = nb * 32; const int mm = n0 < DFF ? n0 : n0 - DFF;
                const int drow = 256 * (mm >> 7) + (mm & 127) + (n0 < DFF ? 0 : 128);
                p0_transpose_item(a.in[12], DM, NUP, WupT, kb * 64, n0, drow, a.in[11], scr, lane); continue; } r -= I_UP;
            { const int kb = r >> 5, nb = r & 31; p0_transpose_item(a.in[15], DFF, DM, WdnT, kb * 64, nb * 32, nb * 32, nullptr, scr, lane); }
        }
        for (int m = gw; m < MT; m += NGW) {
            const float* xr = m < MP ? a.in[0] + (size_t)m * DM : a.in[1] + (size_t)(m - MP) * DM;
            f32x4 v[4]; float s = 0.f;
#pragma unroll
            for (int j = 0; j < 4; ++j) { v[j] = *(const f32x4*)(xr + 4 * lane + 256 * j); s += (v[j][0] * v[j][0] + v[j][1] * v[j][1]) + (v[j][2] * v[j][2] + v[j][3] * v[j][3]); }
            const float rstd = __builtin_amdgcn_rsqf(wave_sum(s) * (1.f / DM) + EPS);
#pragma unroll
            for (int j = 0; j < 4; ++j) { const f32x4 w = *(const f32x4*)(a.in[6] + 4 * lane + 256 * j);
                u32x2 o; o.x = pk2(v[j][0] * rstd * w[0], v[j][1] * rstd * w[1]); o.y = pk2(v[j][2] * rstd * w[2], v[j][3] * rstd * w[3]);
                *(u32x2*)(H1 + (size_t)m * DM + 4 * lane + 256 * j) = o; }
        }
        const int gt = bx * 512 + tid, NGT = G * 512;
        for (int i = gt; i < MT; i += NGT) { RSQ[i] = 0.f; RSQ2[i] = 0.f; }
        for (int i = gt; i < NB * 2 * DM / 2; i += NGT) { const int b = i / DM, c = i - b * DM; ((unsigned*)(X1B + (size_t)b * X1B_PB * DM))[c] = 0u; }
        if (G < 128) cache_copy(a, 0, CC_1, bx, G, tid);
    }
#endif
    if (a.ws == nullptr) grid.sync();
    xcd_barrier(xbar);
#if !defined(ONLY) || ONLY == 1
    REPS(1)
#if (DBL_MASK) & 512
    for (int r_ = 0; r_ < 8; ++r_) xcd_barrier(xbar);
#endif
    {
        const int Gg = G >= 128 ? G - P1_COPY_BLOCKS : G;
        if (bx < Gg) {
        pg8::StaticOrder S; S.init(MT / 256, DIN / 256, Gg, bx);
        AMapStd AM{(const char*)H1, (size_t)256 * DM * 2, (size_t)128 * DM * 2};
        Epi1 E{PROJ, a.out};
        pg8::gemm_phase(lds, WinT, DM, S, AM, E);
        } else cache_copy(a, 0, CC_1, bx - Gg, G - Gg, threadIdx.x);
    }
#endif
    xcd_barrier(xbar);
#if !defined(ONLY) || ONLY == 2
    REPS(2)
    {
        PHASE_IDS
        constexpr int N_S = SBAT * 8, N_A = 32 * 96, N_U = 1024;
        for (int it = bx; it < N_S; it += G) { sample_item(lds, a, PROJ, MIX, it, tid); if ((DBL_MASK) & 1024) sample_item(lds, a, PROJ, MIX, it, tid); }
        {
            const int vb = (G % 8 == 0) ? (bx % 8) * (G / 8) + bx / 8 : bx;
            AttnRegs R; const int it_lo = (int)((long)vb * N_A / G), it_hi = (int)((long)(vb + 1) * N_A / G);
            int it = it_lo;
            bool nl = (it < it_hi) && (attn_decode(it).i0 != 0);
            if (it < it_hi) attn_load(R, PROJ, it, tid, nl);
            while (it < it_hi) {
                const int parity = (it - it_lo) & 1;
                __syncthreads();
                attn_store(lds, R, tid, parity, nl);
                __syncthreads();
                const int nx = it + 1;
                nl = false;
                if (nx < it_hi) attn_load(R, PROJ, nx, tid, false);
                attn_compute(lds, ATTO, ATTML, it, tid, parity);
                it = nx;
            }
        }
        for (int it = bx; it < N_U; it += G) ret_local_item(lds, PROJ, U, it, tid);
    }
#endif
    xcd_barrier(xbar);
#if !defined(ONLY) || ONLY == 3
    REPS(3)
    {
        PHASE_IDS
        for (int idx = bx * 512 + tid; idx < NB * 8 * 4096; idx += G * 512) {
            const int bh = idx >> 12, el = idx & 4095, h = bh & 7;
            const float g128 = ex2(lgam(h) * 128.f);
            float s = 0.f, uv[32];
#pragma unroll
            for (int c = 0; c < 32; ++c) uv[c] = U[((size_t)bh * 32 + c) * 4096 + el];
#pragma unroll
            for (int c = 0; c < 32; ++c) { SIN[((size_t)bh * 32 + c) * 4096 + el] = f2bf(s); s = s * g128 + uv[c]; }
            a.out[O_RETP + idx] = s;
        }
    }
#endif
    xcd_barrier(xbar);
#if !defined(ONLY) || ONLY == 4
    REPS(4)
    { PHASE_IDS
    RetRegs R; int it = bx;
    if (it < 1024) ret_load(R, PROJ, SIN, it, tid);
    while (it < 1024) {
        __syncthreads();
        ret_store(lds, R, tid);
        __syncthreads();
        const int nx = it + G;
        if (nx < 1024) ret_load(R, PROJ, SIN, nx, tid);
        ret_compute(lds, a, PROJ, ATTO, ATTML, MIX, it, tid);
        it = nx;
    }
    __syncthreads(); }
#endif
    xcd_barrier(xbar);
#if !defined(ONLY) || ONLY == 5
    REPS(5)
    {
        pg8::StaticOrder S; S.init(MT / 256, DM / 256, G, bx);
        AMapStd AM{(const char*)MIX, (size_t)256 * DM * 2, (size_t)128 * DM * 2};
        Epi5 E{a.in[0], a.in[1], X1, X1B, RSQ, rep_ == 0};
        pg8::gemm_phase(lds, WoutT, DM, S, AM, E);
        if (bx >= 4) cache_copy(a, CC_1, CC_2, bx - 4, G - 4, threadIdx.x);
    }
#endif
    xcd_barrier(xbar);
#if !defined(ONLY) || ONLY == 6
    REPS(6)
    {
        pg8::StaticOrder S; S.init(69, NUP / 256, G, bx);
        AMapUp AM{(const char*)X1B};
        Epi6 E{RSQ, a.in[13], a.in[14], a.in[5], GB, a.out};
        pg8::gemm_phase(lds, WupT, DM, S, AM, E);
    }
#endif
    xcd_barrier(xbar);
#if !defined(ONLY) || ONLY == 7
    {
        pg8::StaticOrder S; S.init(MT / 256, DM / 256, G, bx);
        AMapStd AM{(const char*)GB, (size_t)256 * DFF * 2, (size_t)128 * DFF * 2};
        Epi7 E{X1B, a.out + O_Y, RSQ2, (unsigned*)(ws + WS_CNT), a.in[16], &a, bx - 4, bx >= 4 ? G - 4 : 0, CC_2, CC_TOT};
        pg8::gemm_phase(lds, WdnT, DFF, S, AM, E);
    }
#endif
}

extern "C" void kernel_launch(void* const* d_in, const int* in_sizes, int n_in, void* d_out, int out_size, void* d_ws, size_t ws_size, hipStream_t stream) {
    static int grid_blocks = 0;
    if (grid_blocks == 0) {
        if (n_in != 17 || ws_size < WS_END) { fprintf(stderr, "kernel_launch: unexpected n_in %d / ws %zu\n", n_in, ws_size); grid_blocks = -1; return; }
        int dev = 0, cus = 0, per_cu = 0;
        hipGetDevice(&dev);
        hipDeviceGetAttribute(&cus, hipDeviceAttributeMultiprocessorCount, dev);
        if (hipFuncSetAttribute((const void*)fwd, hipFuncAttributeMaxDynamicSharedMemorySize, LDS_BYTES) != hipSuccess) { fprintf(stderr, "kernel_launch: hipFuncSetAttribute failed\n"); grid_blocks = -1; return; }
        if (hipOccupancyMaxActiveBlocksPerMultiprocessor(&per_cu, (const void*)fwd, 512, LDS_BYTES) != hipSuccess || per_cu < 1) { fprintf(stderr, "kernel_launch: occupancy query gives %d\n", per_cu); (void)hipGetLastError(); per_cu = 1; }
        grid_blocks = cus * per_cu;
    }
    if (grid_blocks < 0) return;
    if (hipMemsetAsync((char*)d_ws + WS_BAR, 0, BAR_ZERO_BYTES, stream) != hipSuccess) { fprintf(stderr, "kernel_launch: memset failed\n"); return; }
    Args a{};
    for (int i = 0; i < 17; ++i) a.in[i] = (const float*)d_in[i];
    a.out = (float*)d_out; a.ws = (unsigned char*)d_ws;
    void* args[] = {&a};
    hipError_t e = hipLaunchCooperativeKernel((const void*)fwd, dim3(grid_blocks), dim3(512), args, LDS_BYTES, stream);
    if (e != hipSuccess) fprintf(stderr, "cooperative launch failed: %s (grid %d)\n", hipGetErrorString(e), grid_blocks);
}
```

```cpp
#include <hip/hip_runtime.h>
#include <hip/hip_cooperative_groups.h>
#include <cstdio>
#include <cstdint>
namespace cg = cooperative_groups;

#define LAS __attribute__((address_space(3)))
typedef unsigned short bf16_t;
typedef short bf16x8 __attribute__((ext_vector_type(8)));
typedef short s16x4 __attribute__((ext_vector_type(4)));
typedef float f32x4 __attribute__((ext_vector_type(4)));
typedef float f32x2 __attribute__((ext_vector_type(2)));
typedef unsigned u32x4 __attribute__((ext_vector_type(4)));
typedef unsigned u32x2 __attribute__((ext_vector_type(2)));
typedef __bf16 bf16x2_t __attribute__((ext_vector_type(2)));
typedef LAS unsigned char* ldsp;

constexpr int DM = 1024, NB = 4, SEQ = 4096, MP = NB * SEQ, SBAT = 32, STOK = 8, MS = SBAT * STOK, MT = MP + MS;
constexpr int DIN = 3584, DFF = 2816, NUP = 2 * DFF;
constexpr int C_RQ = 0, C_RK = 512, C_RV = 1024, C_RG = 1536, C_AQ = 2048, C_AK = 2560, C_AV = 3072;
constexpr int WINR = 2048;
constexpr float EPS = 1e-6f, LOG2E = 1.4426950408889634f;
constexpr size_t O_Y = 0, O_RETP = 17039360, O_RETS = 17170432, O_WKP = 18219008, O_WVP = 22413312, O_WKS = 26607616, O_WVS = 60162048,
                 O_CVP = 93716480, O_CVS = 93739008;
constexpr size_t MiB = 1u << 20;
constexpr size_t WS_WIN = 0, WS_WOUT = 8 * MiB, WS_WUP = 10 * MiB, WS_WDN = 22 * MiB, WS_RSQ = 28 * MiB, WS_H1 = 32 * MiB, WS_PROJ = 66 * MiB,
                 WS_U = 180 * MiB, WS_SIN = 196 * MiB, WS_ATTO = 204 * MiB, WS_ATTML = 252 * MiB, WS_MIX = 256 * MiB, WS_X1 = 290 * MiB,
                 WS_X1B = 356 * MiB, WS_G = 392 * MiB, WS_END = 484 * MiB;
constexpr size_t WS_BAR = 30 * MiB, WS_CNT = WS_BAR + 16384, BAR_ZERO_BYTES = 16384 + 65 * 256, WS_RSQ2 = WS_RSQ + 128 * 1024;
constexpr int X1B_PB = 4216, X1B_SROW = 16872;
constexpr int LDS_BYTES = 147456;
#ifndef DBL_MASK
#define DBL_MASK 0
#endif
#define REPS(k) for (int rep_ = 0; rep_ < (((DBL_MASK) >> (k)) & 1) + 1; ++rep_)

__device__ __forceinline__ float bf2f(bf16_t b) { return __uint_as_float((unsigned)b << 16); }
__device__ __forceinline__ unsigned pk2(float lo, float hi) { f32x2 v = {lo, hi}; bf16x2_t b = __builtin_convertvector(v, bf16x2_t); return __builtin_bit_cast(unsigned, b); }
__device__ __forceinline__ bf16_t f2bf(float f) { return (bf16_t)(pk2(f, 0.f) & 0xffffu); }
__device__ __forceinline__ float ex2(float x) { return __builtin_amdgcn_exp2f(x); }
__device__ __forceinline__ float silu(float x) { return x * __builtin_amdgcn_rcpf(1.f + ex2(-x * LOG2E)); }
__device__ __forceinline__ float wave_sum(float v) {
#pragma unroll
    for (int o = 1; o < 64; o <<= 1) v += __shfl_xor(v, o);
    return v;
}
__device__ __forceinline__ float wave_max(float v) {
#pragma unroll
    for (int o = 1; o < 64; o <<= 1) v = fmaxf(v, __shfl_xor(v, o));
    return v;
}
#define MFMA16(a, b, c) __builtin_amdgcn_mfma_f32_16x16x32_bf16((a), (b), (c), 0, 0, 0)
typedef short v4i16_t __attribute__((ext_vector_type(4)));
__device__ __forceinline__ s16x4 lds_tr4(ldsp p) { return __builtin_bit_cast(s16x4, __builtin_amdgcn_ds_read_tr16_b64_v4i16((LAS v4i16_t*)p)); }
__device__ __forceinline__ bf16x8 tr_frag(ldsp img, int stride, int r0, int r1, int c0, int fr) {
    const int q = fr >> 2, p = fr & 3;
    const s16x4 lo = lds_tr4(img + (r0 + q) * stride + (c0 + 4 * p) * 2), hi = lds_tr4(img + (r1 + q) * stride + (c0 + 4 * p) * 2);
    return __builtin_shufflevector(lo, hi, 0, 1, 2, 3, 4, 5, 6, 7);
}

namespace pg8 {
constexpr int BM = 256, BK = 64, HALF = 128, HTB = HALF * BK * 2, STAGE_BYTES = 8 * HTB, NXCD = 8, WGM = 8;
__host__ __device__ __forceinline__ int lds_byte(int r, int c) { const int st = (r >> 4) * 2 + (c >> 5), rr = r & 15, cc = c & 31, ob = rr * 64 + cc * 2; return st * 1024 + (ob ^ (((ob >> 9) & 1) << 5)); }
__host__ __device__ __forceinline__ void stage_rc(int b, int& R, int& C) { const int st = b / 1024, sb = b % 1024, swz = sb ^ (((sb >> 9) & 1) << 5); R = (st >> 1) * 16 + swz / 64; C = (st & 1) * 32 + (swz % 64) / 2; }
__host__ __device__ __forceinline__ int perm32(int rho) { const int n = rho >> 4, i = rho & 15; return 8 * (i >> 2) + 4 * n + (i & 3); }
struct Unit { int pm, pn; };
struct ADesc { const char* base; size_t hstep; unsigned delta; };
struct StaticOrder {
    int nM, nN, nwg, G, c;
    __device__ void init(int nM_, int nN_, int G_, int c_) { nM = nM_; nN = nN_; nwg = nM * nN; G = G_; c = c_; }
    __device__ bool next(int i, Unit& u) const {
        const long L = (long)i * G + c; if (L >= nwg) return false;
        int wgid = (int)L; { const int q = nwg / NXCD, r = nwg % NXCD, xcd = wgid % NXCD, off = wgid / NXCD; wgid = (xcd < r ? xcd * (q + 1) : r * (q + 1) + (xcd - r) * q) + off; }
        const int nig = WGM * nN, gid = wgid / nig, fm = gid * WGM, gsz = (nM - fm) < WGM ? (nM - fm) : WGM;
        u.pm = fm + ((wgid % nig) % gsz); u.pn = (wgid % nig) / gsz; return true;
    }
};
template <class Epi, class AMap>
__device__ __forceinline__ void gemm_phase(ldsp lds, const bf16_t* Bt, int K, const StaticOrder& S, const AMap& AM, const Epi& E) {
    int tid_ = threadIdx.x; asm volatile("" : "+v"(tid_));
    const int tid = tid_, wid = __builtin_amdgcn_readfirstlane(tid >> 6), lane = tid & 63, wr = wid >> 2, wc = wid & 3, fr = lane & 15, fq = lane >> 4;
    const int nt = K / BK;
    unsigned voffA[2], voffB[2];
#pragma unroll
    for (int i = 0; i < 2; ++i) { int R, C; stage_rc(tid * 16 + i * 8192, R, C); const int Rb = (R & ~31) + perm32(R & 31);
        voffA[i] = (unsigned)(R * K + C) * 2u; voffB[i] = (unsigned)(Rb * K + C) * 2u; }
    const size_t kstep = (size_t)(BK * 2);
    const size_t hstepB = (size_t)HALF * K * 2;
    const size_t tstepB = 2 * hstepB;
    const unsigned ldsw = (unsigned)wid * 1024u;
    const int aoff = lds_byte(wr * 64 + fr, fq * 8), boff = lds_byte(wc * 32 + fr, fq * 8);
#define PG8_SA(b, h) (((b) * 2 + (h)) * HTB)
#define PG8_SB(b, h) ((4 + (b) * 2 + (h)) * HTB)
#define PG8_STAGEB(bufoff, gbase) do { _Pragma("unroll") for (int _i = 0; _i < 2; ++_i) \
        __builtin_amdgcn_global_load_lds((const unsigned*)((const char*)(gbase) + voffB[_i]), (LAS unsigned*)(lds + (bufoff) + ldsw + _i * 8192), 16, 0, 0); } while (0)
#define PG8_STAGEA(bufoff, gbase, dlt) do { _Pragma("unroll") for (int _i = 0; _i < 2; ++_i) \
        __builtin_amdgcn_global_load_lds((const unsigned*)((const char*)(gbase) + voffA[_i] - (size_t)(_i * (dlt))), (LAS unsigned*)(lds + (bufoff) + ldsw + _i * 8192), 16, 0, 0); } while (0)
#define PG8_LDA(dst, b, h) do { _Pragma("unroll") for (int m = 0; m < 4; ++m) _Pragma("unroll") for (int k = 0; k < 2; ++k) dst[m][k] = *(const LAS bf16x8*)(lds + PG8_SA(b, h) + aoff + m * 2048 + k * 1024); } while (0)
#define PG8_LDB(dst, b, h) do { _Pragma("unroll") for (int n = 0; n < 2; ++n) _Pragma("unroll") for (int k = 0; k < 2; ++k) dst[n][k] = *(const LAS bf16x8*)(lds + PG8_SB(b, h) + boff + n * 2048 + k * 1024); } while (0)
#define PG8_MMA(ai, bj, At, Bt_) do { __builtin_amdgcn_s_setprio(1); _Pragma("unroll") for (int m = 0; m < 4; ++m) _Pragma("unroll") for (int n = 0; n < 2; ++n) _Pragma("unroll") for (int k = 0; k < 2; ++k) \
        acc[ai][bj][m][n] = __builtin_amdgcn_mfma_f32_16x16x32_bf16(Bt_[n][k], At[m][k], acc[ai][bj][m][n], 0, 0, 0); __builtin_amdgcn_s_setprio(0); } while (0)
#define PG8_WAIT_V(n) asm volatile("s_waitcnt vmcnt(" #n ")" ::: "memory")
#define PG8_WAIT_L(n) asm volatile("s_waitcnt lgkmcnt(" #n ")" ::: "memory")
#define PG8_BAR __builtin_amdgcn_s_barrier()
#define PG8_SCHED __builtin_amdgcn_sched_barrier(0)
    Unit cur, nxt; int ui = 0;
    if (!S.next(0, cur)) return;
    f32x4 acc[2][2][4][2];
#pragma unroll
    for (int a = 0; a < 2; ++a)
#pragma unroll
        for (int b = 0; b < 2; ++b)
#pragma unroll
            for (int m = 0; m < 4; ++m)
#pragma unroll
                for (int n = 0; n < 2; ++n) acc[a][b][m][n] = (f32x4){0.f, 0.f, 0.f, 0.f};
    bf16x8 At[4][2], B0[2][2], B1[2][2];
    ADesc cd = AM(cur);
    const char* cA = cd.base; size_t cH = cd.hstep; unsigned cD = cd.delta;
    const char* cB = (const char*)Bt + (size_t)cur.pn * tstepB;
    PG8_STAGEB(PG8_SB(0, 0), cB); PG8_STAGEB(PG8_SB(0, 1), cB + hstepB); PG8_STAGEA(PG8_SA(0, 0), cA, cD); PG8_STAGEA(PG8_SA(0, 1), cA + cH, cD);
    if (wr == 1) PG8_BAR;
    PG8_WAIT_V(2); PG8_BAR;
    PG8_STAGEB(PG8_SB(1, 0), cB + kstep); PG8_STAGEA(PG8_SA(1, 0), cA + kstep, cD); PG8_STAGEB(PG8_SB(1, 1), cB + hstepB + kstep);
    PG8_WAIT_V(6); PG8_BAR;
    for (;;) {
        const bool has_next = S.next(ui + 1, nxt);
        ADesc nd = cd; if (has_next) nd = AM(nxt);
        const char* nA = nd.base; const size_t nH = nd.hstep; const unsigned nD = nd.delta;
        const char* nB = has_next ? (const char*)Bt + (size_t)nxt.pn * tstepB : cB;
        for (int t = 0; t < nt; t += 2) {
            const bool last = (t == nt - 2);
            const char* a1 = cA + (size_t)(t + 1) * kstep;
            const char* a2 = last ? nA : cA + (size_t)(t + 2) * kstep; const char* b2 = last ? nB : cB + (size_t)(t + 2) * kstep;
            const char* a3 = a2 + kstep; const char* b3 = b2 + kstep;
            const size_t h2 = last ? nH : cH; const unsigned d2 = last ? nD : cD;
            PG8_LDB(B0, 0, 0); PG8_LDB(B1, 0, 1); PG8_SCHED; PG8_LDA(At, 0, 0); PG8_STAGEA(PG8_SA(1, 1), a1 + cH, cD);
            PG8_WAIT_V(8); PG8_WAIT_L(0); PG8_BAR; PG8_MMA(0, 0, At, B0); PG8_MMA(0, 1, At, B1); PG8_BAR; PG8_SCHED;
            PG8_LDA(At, 0, 1); PG8_STAGEB(PG8_SB(0, 0), b2); PG8_STAGEB(PG8_SB(0, 1), b2 + hstepB); PG8_STAGEA(PG8_SA(0, 0), a2, d2);
            PG8_WAIT_V(8); PG8_WAIT_L(0); PG8_BAR; PG8_MMA(1, 0, At, B0); PG8_MMA(1, 1, At, B1); PG8_BAR; PG8_SCHED;
            PG8_LDB(B0, 1, 0); PG8_LDB(B1, 1, 1); PG8_SCHED; PG8_LDA(At, 1, 0); PG8_STAGEA(PG8_SA(0, 1), a2 + h2, d2);
            PG8_WAIT_V(8); PG8_WAIT_L(0); PG8_BAR; PG8_MMA(0, 0, At, B0); PG8_MMA(0, 1, At, B1); PG8_BAR; PG8_SCHED;
            PG8_LDA(At, 1, 1); PG8_STAGEB(PG8_SB(1, 0), b3); PG8_STAGEB(PG8_SB(1, 1), b3 + hstepB); PG8_STAGEA(PG8_SA(1, 0), a3, d2);
            PG8_WAIT_V(8); PG8_WAIT_L(0); PG8_BAR; PG8_MMA(1, 0, At, B0); PG8_MMA(1, 1, At, B1); PG8_BAR; PG8_SCHED;
        }
        if (wr == 0) PG8_BAR;
        E(acc, cur, wr, wc, fr, fq);
        if (!has_next) break;
#pragma unroll
        for (int a = 0; a < 2; ++a)
#pragma unroll
            for (int b = 0; b < 2; ++b)
#pragma unroll
                for (int m = 0; m < 4; ++m)
#pragma unroll
                    for (int n = 0; n < 2; ++n) acc[a][b][m][n] = (f32x4){0.f, 0.f, 0.f, 0.f};
        cur = nxt; cA = nA; cB = nB; cH = nH; cD = nD; cd = nd; ++ui;
        if (wr == 1) PG8_BAR;
    }
    PG8_WAIT_V(0);
    PG8_BAR;
#undef PG8_SA
#undef PG8_SB
#undef PG8_STAGEA
#undef PG8_STAGEB
#undef PG8_LDA
#undef PG8_LDB
#undef PG8_MMA
#undef PG8_WAIT_V
#undef PG8_WAIT_L
#undef PG8_BAR
#undef PG8_SCHED
}
}
using pg8::Unit; using pg8::ADesc;
typedef f32x4 Acc[2][2][4][2];

struct AMapStd { const char* A; size_t tstep, hstep; __device__ __forceinline__ ADesc operator()(const Unit& u) const { return ADesc{A + (size_t)u.pm * tstep, hstep, 0u}; } };
struct AMapUp {
    const char* A;
    __device__ __forceinline__ ADesc operator()(const Unit& u) const {
        if (u.pm < 68) return ADesc{A + (size_t)u.pm * 248 * DM * 2, (size_t)124 * DM * 2, 2u * DM * 2u};
        return ADesc{A + (size_t)X1B_SROW * DM * 2, (size_t)128 * DM * 2, 0u};
    }
};

struct Epi1 {
    bf16_t* proj; float* out;
    __device__ __forceinline__ void operator()(const Acc& acc, const Unit& u, int wr, int wc, int fr_, int fq_) const {
        int fr = fr_, fq = fq_; asm volatile("" : "+v"(fr), "+v"(fq));
        const int colb = u.pn * 256 + wc * 32 + 8 * fq;
#pragma unroll
        for (int ai = 0; ai < 2; ++ai)
#pragma unroll
            for (int m = 0; m < 4; ++m) {
                const int row = u.pm * 256 + ai * 128 + wr * 64 + m * 16 + fr;
                float* wrow = nullptr;
                if (u.pn >= 10) {
                    const bool isv = u.pn >= 12;
                    if (row < MP) { const int b = row >> 12, t = row & 4095; if (t >= SEQ - WINR) wrow = out + (isv ? O_WVP : O_WKP) + ((size_t)b * WINR + (t - (SEQ - WINR))) * 512; }
                    else { const int s = row - MP, b = s >> 3, i = s & 7; wrow = out + (isv ? O_WVS : O_WKS) + ((size_t)b * WINR + (WINR - STOK + i)) * 512; }
                }
#pragma unroll
                for (int bj = 0; bj < 2; ++bj) {
                    const f32x4 v0 = acc[ai][bj][m][0], v1 = acc[ai][bj][m][1];
                    const int col = colb + bj * 128;
                    u32x4 w; w.x = pk2(v0[0], v0[1]); w.y = pk2(v0[2], v0[3]); w.z = pk2(v1[0], v1[1]); w.w = pk2(v1[2], v1[3]);
                    *(u32x4*)(proj + (size_t)row * DIN + col) = w;
                    if (wrow) { const int c = (col - C_AK) & 511; *(f32x4*)(wrow + c) = v0; *(f32x4*)(wrow + c + 4) = v1; }
                }
            }
    }
};
struct Epi5 {
    const float* xp; const float* xs; float* x1; bf16_t* x1b; float* rsq; int do_rsq;
    __device__ __forceinline__ void operator()(const Acc& acc, const Unit& u, int wr, int wc, int fr_, int fq_) const {
        int fr = fr_, fq = fq_; asm volatile("" : "+v"(fr), "+v"(fq));
        const int colb = u.pn * 256 + wc * 32 + 8 * fq;
#pragma unroll
        for (int ai = 0; ai < 2; ++ai)
#pragma unroll
            for (int m = 0; m < 4; ++m) {
                const int row = u.pm * 256 + ai * 128 + wr * 64 + m * 16 + fr;
                const float* xrow = row < MP ? xp + (size_t)row * DM : xs + (size_t)(row - MP) * DM;
                const int brow = row < MP ? (row >> 12) * X1B_PB + 2 + (row & 4095) : X1B_SROW + (row - MP);
                float ss = 0.f;
#pragma unroll
                for (int bj = 0; bj < 2; ++bj) {
                    const int col = colb + bj * 128;
                    const f32x4 v0 = acc[ai][bj][m][0] + *(const f32x4*)(xrow + col), v1 = acc[ai][bj][m][1] + *(const f32x4*)(xrow + col + 4);
                    u32x4 w; w.x = pk2(v0[0], v0[1]); w.y = pk2(v0[2], v0[3]); w.z = pk2(v1[0], v1[1]); w.w = pk2(v1[2], v1[3]);
                    *(u32x4*)(x1b + (size_t)brow * DM + col) = w;
                    ss += (v0[0] * v0[0] + v0[1] * v0[1]) + (v0[2] * v0[2] + v0[3] * v0[3]) + (v1[0] * v1[0] + v1[1] * v1[1]) + (v1[2] * v1[2] + v1[3] * v1[3]);
                }
                ss += __shfl_xor(ss, 16); ss += __shfl_xor(ss, 32);
                if (fq == 0 && do_rsq) unsafeAtomicAdd(rsq + row, ss);
            }
    }
};
struct Epi6 {
    const float* rsq; const float* cw; const float* cb; const float* sconv; bf16_t* g; float* out;
    __device__ __forceinline__ void operator()(const Acc& acc, const Unit& u, int wr, int wc, int fr_, int fq_) const {
        int fr = fr_, fq = fq_; asm volatile("" : "+v"(fr), "+v"(fq));
        const bool samp = (u.pm >= 68);
        const int pb = u.pm / 17, pi = u.pm - pb * 17;
        float rstd8[2][4];
#pragma unroll
        for (int ai = 0; ai < 2; ++ai)
#pragma unroll
            for (int m = 0; m < 4; ++m) {
                const int q = ai * 2 + wr, lr = m * 16 + fr; int tok;
                if (!samp) { const int p = pi * 248 + q * 62 + lr - 2; const int pc = p < 0 ? 0 : (p >= SEQ ? SEQ - 1 : p); tok = pb * SEQ + pc; }
                else tok = MP + q * 64 + lr;
                rstd8[ai][m] = rsq[tok];
            }
#pragma unroll
        for (int ai = 0; ai < 2; ++ai)
#pragma unroll
            for (int m = 0; m < 4; ++m) rstd8[ai][m] = __builtin_amdgcn_rsqf(rstd8[ai][m] * (1.0f / DM) + EPS);
        const int c0 = u.pn * 128 + wc * 32 + 8 * fq;
        f32x4 w0[2], w1[2], w2[2], bb[2];
#pragma unroll
        for (int n = 0; n < 2; ++n) { w0[n] = *(const f32x4*)(cw + c0 + 4 * n); w1[n] = *(const f32x4*)(cw + DFF + c0 + 4 * n); w2[n] = *(const f32x4*)(cw + 2 * DFF + c0 + 4 * n); bb[n] = *(const f32x4*)(cb + c0 + 4 * n); }
#pragma unroll
        for (int ai = 0; ai < 2; ++ai) {
            const int q = ai * 2 + wr;
            f32x4 pr1[2], pr2[2];
#pragma unroll
            for (int n = 0; n < 2; ++n) { pr1[n] = (f32x4){0.f, 0.f, 0.f, 0.f}; pr2[n] = (f32x4){0.f, 0.f, 0.f, 0.f}; }
#pragma unroll
            for (int m = 0; m < 4; ++m) {
                const int lr = m * 16 + fr;
                int tok, p = 0, sb = 0, stt = 0; bool valid;
                if (!samp) { p = pi * 248 + q * 62 + lr - 2; valid = (lr >= 2) && (p < SEQ); const int pc = p < 0 ? 0 : (p >= SEQ ? SEQ - 1 : p); tok = pb * SEQ + pc; }
                else { const int s = q * 64 + lr; sb = s >> 3; stt = s & 7; tok = MP + s; valid = true; }
                const float rstd = rstd8[ai][m];
                u32x4 wout; f32x4 uas[2];
#pragma unroll
                for (int n = 0; n < 2; ++n) {
                    const f32x4 ua = acc[ai][0][m][n] * rstd, ub = acc[ai][1][m][n] * rstd;
                    f32x4 r1, r2, o, p1, p2;
#pragma unroll
                    for (int e = 0; e < 4; ++e) { const float uae = ua[e]; const int uai = __float_as_int(uae);
                        r1[e] = __int_as_float(__builtin_amdgcn_update_dpp(0, uai, 0x121, 0xf, 0xf, false));
                        r2[e] = __int_as_float(__builtin_amdgcn_update_dpp(0, uai, 0x122, 0xf, 0xf, false)); }
                    if (!samp) {
#pragma unroll
                        for (int e = 0; e < 4; ++e) { p1[e] = fr >= 1 ? r1[e] : pr1[n][e]; p2[e] = fr >= 2 ? r2[e] : pr2[n][e]; }
                    } else {
                        const float* s0 = sconv + (size_t)sb * 2 * DFF + c0 + 4 * n;
                        const f32x4 sa = *(const f32x4*)s0, sbv = *(const f32x4*)(s0 + DFF);
#pragma unroll
                        for (int e = 0; e < 4; ++e) { p1[e] = stt >= 1 ? r1[e] : sbv[e]; p2[e] = stt >= 2 ? r2[e] : (stt == 1 ? sbv[e] : sa[e]); }
                    }
#pragma unroll
                    for (int e = 0; e < 4; ++e) { const float cv = bb[n][e] + w0[n][e] * p2[e] + w1[n][e] * p1[e] + w2[n][e] * ua[e]; o[e] = silu(cv) * ub[e]; }
                    pr1[n] = r1; pr2[n] = r2; uas[n] = ua;
                    if (n == 0) { wout.x = pk2(o[0], o[1]); wout.y = pk2(o[2], o[3]); } else { wout.z = pk2(o[0], o[1]); wout.w = pk2(o[2], o[3]); }
                }
                if (valid) {
                    *(u32x4*)(g + (size_t)tok * DFF + c0) = wout;
                    float* so = nullptr;
                    if (!samp) { if (p >= SEQ - 2) so = out + O_CVP + ((size_t)pb * 2 + (p - (SEQ - 2))) * DFF + c0; }
                    else { if (stt >= 6) so = out + O_CVS + ((size_t)sb * 2 + (stt - 6)) * DFF + c0; }
                    if (so) { *(f32x4*)so = uas[0]; *(f32x4*)(so + 4) = uas[1]; }
                }
            }
        }
    }
};
struct Args;
__device__ __forceinline__ void cache_copy(const Args& a, int lo, int hi, int worker, int nw, int tid);
struct Epi7 {
    const bf16_t* x1b; float* y; float* rsq2; unsigned* cnt; const float* wf; const Args* args; int copy_worker, copy_nw, copy_lo, copy_hi;
    __device__ __forceinline__ void operator()(Acc& acc, const Unit& u, int wr, int wc, int fr_, int fq_) const {
        int fr = fr_, fq = fq_; asm volatile("" : "+v"(fr), "+v"(fq));
        const int colb = u.pn * 256 + wc * 32 + 8 * fq;
#pragma unroll
        for (int ai = 0; ai < 2; ++ai)
#pragma unroll
            for (int m = 0; m < 4; ++m) {
                const int row = u.pm * 256 + ai * 128 + wr * 64 + m * 16 + fr;
                const int brow = row < MP ? (row >> 12) * X1B_PB + 2 + (row & 4095) : X1B_SROW + (row - MP);
                float ss = 0.f;
#pragma unroll
                for (int bj = 0; bj < 2; ++bj) {
                    const int col = colb + bj * 128;
                    const u32x4 r = *(const u32x4*)(x1b + (size_t)brow * DM + col);
                    const f32x4 r0 = {__uint_as_float(r.x << 16), __uint_as_float(r.x & 0xffff0000u), __uint_as_float(r.y << 16), __uint_as_float(r.y & 0xffff0000u)};
                    const f32x4 r1 = {__uint_as_float(r.z << 16), __uint_as_float(r.z & 0xffff0000u), __uint_as_float(r.w << 16), __uint_as_float(r.w & 0xffff0000u)};
                    const f32x4 v0 = acc[ai][bj][m][0] + r0, v1 = acc[ai][bj][m][1] + r1;
                    acc[ai][bj][m][0] = v0; acc[ai][bj][m][1] = v1;
                    ss += (v0[0] * v0[0] + v0[1] * v0[1]) + (v0[2] * v0[2] + v0[3] * v0[3]) + (v1[0] * v1[0] + v1[1] * v1[1]) + (v1[2] * v1[2] + v1[3] * v1[3]);
                }
                ss += __shfl_xor(ss, 16); ss += __shfl_xor(ss, 32);
                if (fq == 0) unsafeAtomicAdd(rsq2 + row, ss);
            }
        asm volatile("s_waitcnt vmcnt(0)" ::: "memory");
        unsigned* pc = cnt + 64 * u.pm;
        if ((threadIdx.x & 63) == 0) __hip_atomic_fetch_add(pc, 1u, __ATOMIC_RELAXED, __HIP_MEMORY_SCOPE_AGENT);
        if (copy_nw > 0) cache_copy(*args, copy_lo, copy_hi, copy_worker, copy_nw, threadIdx.x);
        {
            unsigned sp = 0;
            while (__hip_atomic_load(pc, __ATOMIC_RELAXED, __HIP_MEMORY_SCOPE_AGENT) < 32u) { __builtin_amdgcn_s_sleep(4); if (++sp > (1u << 22)) break; }
            asm volatile("" ::: "memory");
        }
        f32x4 wv[2][2];
#pragma unroll
        for (int bj = 0; bj < 2; ++bj) { wv[bj][0] = *(const f32x4*)(wf + colb + bj * 128); wv[bj][1] = *(const f32x4*)(wf + colb + bj * 128 + 4); }
#pragma unroll
        for (int ai = 0; ai < 2; ++ai)
#pragma unroll
            for (int m = 0; m < 4; ++m) {
                const int row = u.pm * 256 + ai * 128 + wr * 64 + m * 16 + fr;
                const float rstd = __builtin_amdgcn_rsqf(__hip_atomic_load(rsq2 + row, __ATOMIC_RELAXED, __HIP_MEMORY_SCOPE_AGENT) * (1.0f / DM) + EPS);
                const size_t ro = (size_t)row * DM;
#pragma unroll
                for (int bj = 0; bj < 2; ++bj) {
                    const int col = colb + bj * 128;
                    *(f32x4*)(y + ro + col) = acc[ai][bj][m][0] * rstd * wv[bj][0];
                    *(f32x4*)(y + ro + col + 4) = acc[ai][bj][m][1] * rstd * wv[bj][1];
                }
            }
    }
};

#define XB_TMO      128
#define XB_XCNT(j)  (256  + 64 * (j))
#define XB_XSUB(j)  (1280 + 64 * (j))
#define XB_XGEN(j)  (2304 + 64 * (j))
#define XB_TOP      3328
#define XB_TOPGEN   3392
#define XCD_BAR_WORDS 3456
#define XB_SPIN_CAP (1u << 20)
__device__ __forceinline__ unsigned xb_ld(unsigned* p)              { return __hip_atomic_load(p, __ATOMIC_RELAXED, __HIP_MEMORY_SCOPE_AGENT); }
__device__ __forceinline__ unsigned xb_add(unsigned* p, unsigned v) { return __hip_atomic_fetch_add(p, v, __ATOMIC_RELAXED, __HIP_MEMORY_SCOPE_AGENT); }
__device__ __forceinline__ unsigned xb_xcc_id() { return (unsigned)__builtin_amdgcn_s_getreg((3 << 11) | 20) & 0xFu; }
#define XB_SPIN(cond, bar) do { unsigned _sp = 0; while (cond) { __builtin_amdgcn_s_sleep(1); \
    if ((++_sp & 255u) == 0u) { if (xb_ld(&(bar)[XB_TMO])) break; if (_sp > XB_SPIN_CAP) { atomicAdd(&(bar)[XB_TMO], 1u); break; } } } } while (0)
struct XcdBarrier { unsigned* bar; unsigned x; volatile LAS unsigned* st; };
__device__ __forceinline__ XcdBarrier xcd_barrier_post(unsigned* bar, volatile LAS unsigned* st) {
    XcdBarrier b; b.bar = bar; b.x = xb_xcc_id(); b.st = st;
    if (threadIdx.x == 0) (void)xb_add(&bar[XB_XCNT(b.x)], 1u);
    return b;
}
__device__ __forceinline__ void xcd_barrier_complete(unsigned* bar, unsigned x, unsigned& nloc, unsigned& nx) {
    const unsigned G = gridDim.x * gridDim.y * gridDim.z;
    unsigned sum, cnt, mine, sp = 0u;
    for (;;) {
        sum = 0u; cnt = 0u; mine = 0u;
#pragma unroll
        for (unsigned j = 0; j < 16; ++j) { const unsigned c = xb_ld(&bar[XB_XCNT(j)]); sum += c; cnt += (c > 0u) ? 1u : 0u; mine = (j == x) ? c : mine; }
        if (sum == G) break;
        __builtin_amdgcn_s_sleep(1);
        if ((++sp & 255u) == 0u) { if (xb_ld(&bar[XB_TMO])) break; if (sp > XB_SPIN_CAP) { atomicAdd(&bar[XB_TMO], 1u); break; } }
    }
    nloc = mine > 0u ? mine : 1u; nx = cnt > 0u ? cnt : 1u;
}
__device__ __forceinline__ void xcd_barrier(const XcdBarrier& b) {
    asm volatile("s_waitcnt vmcnt(0)" ::: "memory");
    __syncthreads();
    if (threadIdx.x == 0) {
        unsigned* bar = b.bar;
        __builtin_amdgcn_s_waitcnt(0);
        unsigned nloc = b.st[0], nx = b.st[1];
        if (nloc == 0u) { xcd_barrier_complete(bar, b.x, nloc, nx); b.st[0] = nloc; b.st[1] = nx; }
        const unsigned old = xb_add(&bar[XB_XSUB(b.x)], 1u);
        const unsigned gen = old / nloc;
        if (old + 1u == (gen + 1u) * nloc) {
            __builtin_amdgcn_fence(__ATOMIC_RELEASE, "agent");
            asm volatile("s_waitcnt vmcnt(0)" ::: "memory");
            const unsigned og = xb_add(&bar[XB_TOP], 1u);
            const unsigned tg = og / nx;
            if (og + 1u == (tg + 1u) * nx) xb_add(&bar[XB_TOPGEN], 1u);
            else XB_SPIN(xb_ld(&bar[XB_TOPGEN]) == tg, bar);
            __builtin_amdgcn_fence(__ATOMIC_ACQUIRE, "agent");
            xb_add(&bar[XB_XGEN(b.x)], 1u);
            asm volatile("s_waitcnt vmcnt(0)" ::: "memory");
        } else {
            XB_SPIN(xb_ld(&bar[XB_XGEN(b.x)]) == gen, bar);
            __builtin_amdgcn_fence(__ATOMIC_ACQUIRE, "agent");
            asm volatile("s_waitcnt vmcnt(0)" ::: "memory");
        }
    }
    __syncthreads();
}

struct Args { const float* in[17]; float* out; unsigned char* ws; };

__device__ __forceinline__ void p0_transpose_item(const float* W, int K, int N, bf16_t* WT, int k0, int n0, int drow0, const float* kscale, LAS float* scr, int lane) {
    float wv[32];
#pragma unroll
    for (int i = 0; i < 32; ++i) wv[i] = W[(size_t)(k0 + 2 * i + (lane >> 5)) * N + n0 + (lane & 31)];
    if (kscale) {
#pragma unroll
        for (int i = 0; i < 32; ++i) wv[i] *= kscale[k0 + 2 * i + (lane >> 5)];
    }
#pragma unroll
    for (int i = 0; i < 32; ++i) scr[(2 * i + (lane >> 5)) * 33 + (lane & 31)] = wv[i];
    asm volatile("s_waitcnt lgkmcnt(0)" ::: "memory");
    const int c = lane & 7;
#pragma unroll
    for (int j = 0; j < 4; ++j) { const int n = (lane >> 3) + 8 * j; const LAS float* s = scr + (8 * c) * 33 + n;
        u32x4 o; o.x = pk2(s[0 * 33], s[1 * 33]); o.y = pk2(s[2 * 33], s[3 * 33]); o.z = pk2(s[4 * 33], s[5 * 33]); o.w = pk2(s[6 * 33], s[7 * 33]);
        *(u32x4*)(WT + (size_t)(drow0 + n) * K + k0 + 8 * c) = o; }
    asm volatile("s_waitcnt lgkmcnt(0)" ::: "memory");
}

__device__ __forceinline__ float lgam(int h) { return __logf(1.f - ex2(-5.f - (float)h)) * LOG2E; }

__device__ __forceinline__ void ret_local_item(ldsp lds, const bf16_t* proj, float* U, int item, int tid) {
    const int lane = tid & 63, wave = tid >> 6, fr = lane & 15, g = lane >> 4;
    const int bh = item >> 5, c = item & 31, b = bh >> 3, h = bh & 7;
    const float l2g = lgam(h);
    constexpr int RS = 144;
    ldsp KT = lds, VT = lds + 128 * RS;
    const size_t tok0 = (size_t)b * SEQ + c * 128;
    __syncthreads();
#pragma unroll
    for (int u = 0; u < 2; ++u) {
        const int idx = u * 512 + tid, j = idx >> 3, ch = idx & 7;
        const bf16_t* src = proj + (tok0 + j) * DIN + h * 64 + ch * 8;
        const u32x4 kv = *(const u32x4*)(src + C_RK), vv = *(const u32x4*)(src + C_RV);
        const float dec = 0.125f * ex2(l2g * (float)(127 - j));
        u32x4 kd;
#pragma unroll
        for (int e = 0; e < 4; ++e) { const unsigned kw = kv[e]; kd[e] = pk2(__uint_as_float(kw << 16) * dec, __uint_as_float(kw & 0xffff0000u) * dec); }
        *(LAS u32x4*)(KT + j * RS + ch * 16) = kd; *(LAS u32x4*)(VT + j * RS + ch * 16) = vv;
    }
    __syncthreads();
    float* Uo = U + (size_t)item * 4096;
#pragma unroll
    for (int t = 0; t < 2; ++t) {
        const int tile = wave * 2 + t, ti = tile >> 2, tj = tile & 3;
        f32x4 acc = {0.f, 0.f, 0.f, 0.f};
#pragma unroll
        for (int ks = 0; ks < 4; ++ks) {
            const bf16x8 a = tr_frag(KT, RS, ks * 32 + g * 8, ks * 32 + g * 8 + 4, ti * 16, fr);
            const bf16x8 bb = tr_frag(VT, RS, ks * 32 + g * 8, ks * 32 + g * 8 + 4, tj * 16, fr);
            acc = MFMA16(a, bb, acc);
        }
#pragma unroll
        for (int jj = 0; jj < 4; ++jj) Uo[(ti * 16 + 4 * g + jj) * 64 + tj * 16 + fr] = acc[jj];
    }
}

struct AttnRegs { u32x4 qv[2], kv[4], vv[4]; };
struct AttnItem { int b, h, br, d, r, i0; };
__device__ __forceinline__ AttnItem attn_decode(int item) {
    AttnItem t; const int bh = item / 96, rem = item - bh * 96, ci = rem & 31; t.br = rem >> 5; t.b = bh >> 3; t.h = bh & 7;
    const int dsh = 2 * t.br, cps = 32 >> dsh; t.d = 1 << dsh; t.r = ci / cps; t.i0 = (ci - t.r * cps) * 128; return t;
}
__device__ __forceinline__ void attn_load(AttnRegs& R, const bf16_t* proj, int item, int tid, bool need_lower) {
    const AttnItem t = attn_decode(item);
    const size_t tb = (size_t)t.b * SEQ + t.r; const int d = t.d, i0 = t.i0, h = t.h;
#pragma unroll
    for (int u = 0; u < 2; ++u) { const int idx = u * 512 + tid, row = idx >> 3, ch = idx & 7;
        R.qv[u] = *(const u32x4*)(proj + (tb + (size_t)(i0 + row) * d) * DIN + C_AQ + h * 64 + ch * 8); }
#pragma unroll
    for (int u = 0; u < 2; ++u) { const int idx = u * 512 + tid, row = idx >> 3, ch = idx & 7;
        const bf16_t* src = proj + (tb + (size_t)(i0 + row) * d) * DIN + h * 64 + ch * 8;
        R.kv[u] = *(const u32x4*)(src + C_AK); R.vv[u] = *(const u32x4*)(src + C_AV); }
    if (need_lower) {
#pragma unroll
        for (int u = 0; u < 2; ++u) { const int idx = u * 512 + tid, row = idx >> 3, ch = idx & 7;
            const bf16_t* src = proj + (tb + (size_t)(i0 - 128 + row) * d) * DIN + h * 64 + ch * 8;
            R.kv[2 + u] = *(const u32x4*)(src + C_AK); R.vv[2 + u] = *(const u32x4*)(src + C_AV); }
    }
}
constexpr int AT_QS = 144, AT_VS = 528;
__device__ __forceinline__ void attn_store(ldsp lds, const AttnRegs& R, int tid, int parity, bool need_lower) {
    ldsp Qs = lds, Ks = lds + 128 * AT_QS, VT = Ks + 256 * AT_QS;
    const int up = parity * 128, lo = (1 - parity) * 128;
#pragma unroll
    for (int u = 0; u < 2; ++u) { const int idx = u * 512 + tid, row = idx >> 3, ch = idx & 7;
        *(LAS u32x4*)(Qs + row * AT_QS + ch * 16) = R.qv[u];
        *(LAS u32x4*)(Ks + (up + row) * AT_QS + ch * 16) = R.kv[u]; *(LAS u32x4*)(VT + (up + row) * AT_QS + ch * 16) = R.vv[u]; }
    if (need_lower) {
#pragma unroll
        for (int u = 0; u < 2; ++u) { const int idx = u * 512 + tid, row = idx >> 3, ch = idx & 7;
            *(LAS u32x4*)(Ks + (lo + row) * AT_QS + ch * 16) = R.kv[2 + u]; *(LAS u32x4*)(VT + (lo + row) * AT_QS + ch * 16) = R.vv[2 + u]; }
    }
}
__device__ __forceinline__ void attn_compute(ldsp lds, bf16_t* atto, float* attml, int item, int tid, int parity) {
    constexpr int QS = AT_QS, VS = AT_VS;
    const int lane = tid & 63, wave = __builtin_amdgcn_readfirstlane(tid >> 6), fr = lane & 15, g = lane >> 4;
    const AttnItem t = attn_decode(item);
    const int d = t.d, i0 = t.i0, h = t.h, br = t.br;
    const size_t tb = (size_t)t.b * SEQ + t.r;
    const bool first = (i0 == 0);
    ldsp Qs = lds, Ks = lds + 128 * QS, VT = Ks + 256 * QS;
    const int qi0 = wave * 16, qi = qi0 + fr;
    const bf16x8 bq0 = *(const LAS bf16x8*)(Qs + qi * QS + g * 16), bq1 = *(const LAS bf16x8*)(Qs + qi * QS + 64 + g * 16);
    const float slope = ex2(-(float)(h + 1));
    const float sc = 0.125f * LOG2E, sl = slope * (float)d * LOG2E;
    float mrun = -1e30f, lsum = 0.f;
    f32x4 ot[4];
#pragma unroll
    for (int et = 0; et < 4; ++et) ot[et] = (f32x4){0.f, 0.f, 0.f, 0.f};
    int kt_lo = qi0 >> 5; if (first && kt_lo < 4) kt_lo = 4;
    const int kt_hi = (qi0 + 15 + 128) >> 5;
#define AT_KB(kt) (((((kt) >> 2) ^ parity ^ 1) & 1) << 7 | (((kt) & 3) << 5))
    bf16x8 kf[2][2][2];
    {
        const int k1 = (kt_lo + 1 <= kt_hi) ? kt_lo + 1 : kt_lo; const int kb0 = AT_KB(kt_lo), kb1 = AT_KB(k1);
#pragma unroll
        for (int hf = 0; hf < 2; ++hf) {
            ldsp kp0 = Ks + (kb0 + hf * 16 + fr) * QS + g * 16; ldsp kp1 = Ks + (kb1 + hf * 16 + fr) * QS + g * 16;
            kf[0][hf][0] = *(const LAS bf16x8*)kp0; kf[0][hf][1] = *(const LAS bf16x8*)(kp0 + 64);
            kf[1][hf][0] = *(const LAS bf16x8*)kp1; kf[1][hf][1] = *(const LAS bf16x8*)(kp1 + 64);
        }
    }
    for (int kt0 = kt_lo; kt0 <= kt_hi; kt0 += 2) {
        const bool two = (kt0 + 1 <= kt_hi);
        const int ktv[2] = {kt0, two ? kt0 + 1 : kt0};
        int kbv[2];
#pragma unroll
        for (int tt = 0; tt < 2; ++tt) kbv[tt] = AT_KB(ktv[tt]);
        f32x4 st[4];
#pragma unroll
        for (int tt = 0; tt < 2; ++tt)
#pragma unroll
            for (int hf = 0; hf < 2; ++hf) {
                st[tt * 2 + hf] = MFMA16(kf[tt][hf][0], bq0, ((f32x4){0.f, 0.f, 0.f, 0.f}));
                st[tt * 2 + hf] = MFMA16(kf[tt][hf][1], bq1, st[tt * 2 + hf]);
            }
        bf16x8 vf[2][4];
#pragma unroll
        for (int tt = 0; tt < 2; ++tt)
#pragma unroll
            for (int et = 0; et < 4; ++et) vf[tt][et] = tr_frag(VT, QS, kbv[tt] + 4 * g, kbv[tt] + 16 + 4 * g, et * 16, fr);
        {
            const int n0 = (kt0 + 2 <= kt_hi) ? kt0 + 2 : kt_hi, n1 = (kt0 + 3 <= kt_hi) ? kt0 + 3 : kt_hi; const int kb0 = AT_KB(n0), kb1 = AT_KB(n1);
#pragma unroll
            for (int hf = 0; hf < 2; ++hf) {
                ldsp kp0 = Ks + (kb0 + hf * 16 + fr) * QS + g * 16; ldsp kp1 = Ks + (kb1 + hf * 16 + fr) * QS + g * 16;
                kf[0][hf][0] = *(const LAS bf16x8*)kp0; kf[0][hf][1] = *(const LAS bf16x8*)(kp0 + 64);
                kf[1][hf][0] = *(const LAS bf16x8*)kp1; kf[1][hf][1] = *(const LAS bf16x8*)(kp1 + 64);
            }
        }
        float s[16]; float tmax = -INFINITY;
#pragma unroll
        for (int tt = 0; tt < 2; ++tt)
#pragma unroll
            for (int hf = 0; hf < 2; ++hf)
#pragma unroll
                for (int jj = 0; jj < 4; ++jj) {
                    const int kj = ktv[tt] * 32 + hf * 16 + 4 * g + jj, dist = qi + 128 - kj;
                    const bool ok = ((unsigned)dist <= 128u) && (tt == 0 || two);
                    const float v = ok ? st[tt * 2 + hf][jj] * sc - sl * (float)dist : -INFINITY;
                    s[tt * 8 + hf * 4 + jj] = v; tmax = fmaxf(tmax, v);
                }
        tmax = fmaxf(tmax, __shfl_xor(tmax, 16)); tmax = fmaxf(tmax, __shfl_xor(tmax, 32));
        const float mnew = fmaxf(mrun, tmax), alpha = ex2(mrun - mnew); mrun = mnew;
        float ps = 0.f;
#pragma unroll
        for (int e = 0; e < 16; ++e) { s[e] = ex2(s[e] - mnew); ps += s[e]; }
        lsum = lsum * alpha + ps;
#pragma unroll
        for (int et = 0; et < 4; ++et) ot[et] = ot[et] * alpha;
#pragma unroll
        for (int tt = 0; tt < 2; ++tt) {
            u32x4 pw; pw.x = pk2(s[tt * 8 + 0], s[tt * 8 + 1]); pw.y = pk2(s[tt * 8 + 2], s[tt * 8 + 3]); pw.z = pk2(s[tt * 8 + 4], s[tt * 8 + 5]); pw.w = pk2(s[tt * 8 + 6], s[tt * 8 + 7]);
            const bf16x8 pf = __builtin_bit_cast(bf16x8, pw);
#pragma unroll
            for (int et = 0; et < 4; ++et) ot[et] = MFMA16(vf[tt][et], pf, ot[et]);
        }
    }
#undef AT_KB
    lsum += __shfl_xor(lsum, 16); lsum += __shfl_xor(lsum, 32);
    const float inv = __builtin_amdgcn_rcpf(lsum);
    const size_t tok = tb + (size_t)(i0 + qi) * d;
    bf16_t* od = atto + ((size_t)br * MP + tok) * 512 + h * 64;
#pragma unroll
    for (int et = 0; et < 4; ++et) { u32x2 w; w.x = pk2(ot[et][0] * inv, ot[et][1] * inv); w.y = pk2(ot[et][2] * inv, ot[et][3] * inv);
        *(u32x2*)(od + et * 16 + 4 * g) = w; }
    if (g == 0) { f32x2 ml = {mrun, lsum}; *(f32x2*)(attml + (((size_t)br * MP + tok) * 8 + h) * 2) = ml; }
}

__device__ __forceinline__ void sample_item(ldsp lds, const Args& a, const bf16_t* proj, bf16_t* mix, int item, int tid) {
    const int lane = tid & 63, wave = tid >> 6, b = item >> 3, h = item & 7;
    LAS float* qs = (LAS float*)lds;
    LAS float* ks = qs + 512;
    LAS float* vs = ks + 512;
    LAS float* aq = vs + 512;
    LAS float* sc = aq + 512;
    LAS float* part = sc + 64;
    LAS float* pbuf = part + 4096;
    const float l2g = lgam(h);
    __syncthreads();
    {
        const int i = tid >> 6, e = tid & 63;
        const bf16_t* src = proj + (size_t)(MP + b * 8 + i) * DIN + h * 64 + e;
        qs[tid] = bf2f(src[C_RQ]); ks[tid] = bf2f(src[C_RK]) * 0.125f; vs[tid] = bf2f(src[C_RV]); aq[tid] = bf2f(src[C_AQ]) * 0.125f;
    }
    __syncthreads();
    if (tid < 64) { const int i = tid >> 3, j = tid & 7; float s = 0.f;
        if (j <= i) {
#pragma unroll 4
            for (int dd = 0; dd < 64; ++dd) s += qs[i * 64 + dd] * ks[j * 64 + dd];
            s *= ex2(l2g * (float)(i - j)); }
        sc[tid] = s; }
    {
        const int e = tid & 63, dkg = tid >> 6;
        const float* S0 = a.in[2] + ((size_t)(b * 8 + h) * 64 + dkg * 8) * 64 + e;
        float* So = a.out + O_RETS + ((size_t)(b * 8 + h) * 64 + dkg * 8) * 64 + e;
        float cr[8];
#pragma unroll
        for (int i = 0; i < 8; ++i) cr[i] = 0.f;
        const float g8 = ex2(l2g * 8.f);
        float vd[8];
#pragma unroll
        for (int i = 0; i < 8; ++i) vd[i] = ex2(l2g * (float)(7 - i)) * vs[i * 64 + e];
        float s0v[8];
#pragma unroll
        for (int k = 0; k < 8; ++k) s0v[k] = S0[k * 64];
#pragma unroll
        for (int k = 0; k < 8; ++k) {
            const int dk = dkg * 8 + k; const float s0 = s0v[k];
            float sn = s0 * g8;
#pragma unroll
            for (int i = 0; i < 8; ++i) { cr[i] += qs[i * 64 + dk] * s0; sn += ks[i * 64 + dk] * vd[i]; }
            So[k * 64] = sn;
        }
#pragma unroll
        for (int i = 0; i < 8; ++i) part[(dkg * 8 + i) * 64 + e] = cr[i];
    }
    __syncthreads();
    {
        const int i = wave, e = lane; float o = 0.f;
#pragma unroll
        for (int dkg = 0; dkg < 8; ++dkg) o += part[(dkg * 8 + i) * 64 + e];
        o *= ex2(l2g * (float)(i + 1));
        for (int j = 0; j <= i; ++j) o += sc[i * 8 + j] * vs[j * 64 + e];
        const float mu = wave_sum(o) * (1.f / 64.f), dv = o - mu, var = wave_sum(dv * dv) * (1.f / 64.f);
        const float nrm = dv * __builtin_amdgcn_rsqf(var + EPS) * a.in[8][h * 64 + e] + a.in[9][h * 64 + e];
        const size_t tok = (size_t)MP + b * 8 + i;
        const float gate = bf2f(proj[tok * DIN + C_RG + h * 64 + e]);
        mix[tok * DM + h * 64 + e] = f2bf(silu(gate) * nrm);
    }
    {
        const int i = wave, kg = lane >> 4, dc = lane & 15;
        const float* ck = a.in[3] + (size_t)b * WINR * 512 + h * 64 + 4 * dc; const float* cvp = a.in[4] + (size_t)b * WINR * 512 + h * 64 + 4 * dc;
        const float* nk = a.out + O_WKS + ((size_t)b * WINR + (WINR - STOK)) * 512 + h * 64 + 4 * dc; const float* nv = a.out + O_WVS + ((size_t)b * WINR + (WINR - STOK)) * 512 + h * 64 + 4 * dc;
        const float slope = ex2(-(float)(h + 1));
        LAS float* pw = pbuf + wave * 448;
        const f32x4 q4 = *(const LAS f32x4*)(aq + i * 64 + 4 * dc);
#pragma unroll 1
        for (int it0 = 0; it0 < 99; it0 += 33)
#pragma unroll
        for (int iu = 0; iu < 33; ++iu) {
            const int idx = (it0 + iu) * 4 + kg, idc = idx < 387 ? idx : 386;
            const int br = idc >= 258 ? 2 : (idc >= 129 ? 1 : 0), n = idc - br * 129, dist = n << (2 * br), loc = WINR + i - dist;
            const float* kr = loc < WINR ? ck + (size_t)loc * 512 : nk + (size_t)(loc - WINR) * 512;
            const f32x4 kk = *(const f32x4*)kr;
            float dot = (kk[0] * q4[0] + kk[1] * q4[1]) + (kk[2] * q4[2] + kk[3] * q4[3]);
            dot += __int_as_float(__builtin_amdgcn_update_dpp(0, __float_as_int(dot), 0x128, 0xf, 0xf, false));
            dot += __int_as_float(__builtin_amdgcn_update_dpp(0, __float_as_int(dot), 0x124, 0xf, 0xf, false));
            dot += __int_as_float(__builtin_amdgcn_update_dpp(0, __float_as_int(dot), 0x122, 0xf, 0xf, false));
            dot += __int_as_float(__builtin_amdgcn_update_dpp(0, __float_as_int(dot), 0x121, 0xf, 0xf, false));
            if (dc == 0 && idx < 387) pw[idx] = (dot - slope * (float)dist) * LOG2E;
        }
        asm volatile("s_waitcnt lgkmcnt(0)" ::: "memory");
        float mx = -INFINITY;
        for (int u = 0; u < 7; ++u) { const int idx = u * 64 + lane; if (idx < 387) mx = fmaxf(mx, pw[idx]); }
        mx = wave_max(mx);
        float ssum = 0.f;
        for (int u = 0; u < 7; ++u) { const int idx = u * 64 + lane; if (idx < 387) { const float p = ex2(pw[idx] - mx); pw[idx] = p; ssum += p; } }
        ssum = wave_sum(ssum);
        asm volatile("s_waitcnt lgkmcnt(0)" ::: "memory");
        f32x4 o = {0.f, 0.f, 0.f, 0.f};
#pragma unroll 1
        for (int it0 = 0; it0 < 99; it0 += 33)
#pragma unroll
        for (int iu = 0; iu < 33; ++iu) {
            const int idx = (it0 + iu) * 4 + kg, idc = idx < 387 ? idx : 386;
            const int br = idc >= 258 ? 2 : (idc >= 129 ? 1 : 0), n = idc - br * 129, loc = WINR + i - (n << (2 * br));
            const float* vr = loc < WINR ? cvp + (size_t)loc * 512 : nv + (size_t)(loc - WINR) * 512;
            const float p = idx < 387 ? pw[idc] : 0.f;
            o = o + *(const f32x4*)vr * p;
        }
#pragma unroll
        for (int e = 0; e < 4; ++e) { o[e] += __shfl_xor(o[e], 16); o[e] += __shfl_xor(o[e], 32); }
        if (kg == 0) {
            const float inv = 1.f / ssum; const size_t tok = (size_t)MP + b * 8 + i;
            u32x2 w; w.x = pk2(o[0] * inv, o[1] * inv); w.y = pk2(o[2] * inv, o[3] * inv);
            *(u32x2*)(mix + tok * DM + 512 + h * 64 + 4 * dc) = w;
        }
    }
}

struct RetRegs { u32x4 q[2], k[2], v[2], s; };
__device__ __forceinline__ void ret_load(RetRegs& R, const bf16_t* proj, const bf16_t* sin, int item, int tid) {
    const int bh = item >> 5, c = item & 31, b = bh >> 3, h = bh & 7;
    const size_t tok0 = (size_t)b * SEQ + c * 128;
#pragma unroll
    for (int u = 0; u < 2; ++u) {
        const int idx = u * 512 + tid, row = idx >> 3, ch = idx & 7; const bf16_t* src = proj + (tok0 + row) * DIN + h * 64 + ch * 8;
        R.q[u] = *(const u32x4*)(src + C_RQ); R.k[u] = *(const u32x4*)(src + C_RK); R.v[u] = *(const u32x4*)(src + C_RV);
    }
    { const int dk = tid >> 3, ch = tid & 7; R.s = *(const u32x4*)(sin + (size_t)item * 4096 + dk * 64 + ch * 8); }
}
__device__ __forceinline__ void ret_store(ldsp lds, const RetRegs& R, int tid) {
    constexpr int QS = 144;
    ldsp Qs = lds, Ks = lds + 128 * QS, VT = Ks + 128 * QS, STt = VT + 128 * QS;
#pragma unroll
    for (int u = 0; u < 2; ++u) {
        const int idx = u * 512 + tid, row = idx >> 3, ch = idx & 7;
        *(LAS u32x4*)(Qs + row * QS + ch * 16) = R.q[u]; *(LAS u32x4*)(Ks + row * QS + ch * 16) = R.k[u]; *(LAS u32x4*)(VT + row * QS + ch * 16) = R.v[u];
    }
    { const int dk = tid >> 3, ch = tid & 7; *(LAS u32x4*)(STt + dk * QS + ch * 16) = R.s; }
}
__device__ __forceinline__ void ret_compute(ldsp lds, const Args& a, const bf16_t* proj, const bf16_t* atto, const float* attml, bf16_t* mix, int item, int tid) {
    const int lane = tid & 63, wave = __builtin_amdgcn_readfirstlane(tid >> 6), fr = lane & 15, g = lane >> 4;
    const int bh = item >> 5, c = item & 31, b = bh >> 3, h = bh & 7;
    const float l2g = lgam(h);
    constexpr int QS = 144;
    ldsp Qs = lds, Ks = lds + 128 * QS, VT = Ks + 128 * QS, STt = VT + 128 * QS;
    const size_t tok0 = (size_t)b * SEQ + c * 128;
    const int mt = tid >> 2, meg = (tid & 3) * 16; const size_t mtk = tok0 + mt;
    f32x2 mml[3]; u32x4 mv0[3], mv1[3];
#pragma unroll
    for (int br = 0; br < 3; ++br) { mml[br] = *(const f32x2*)(attml + (((size_t)br * MP + mtk) * 8 + h) * 2);
        const bf16_t* src = atto + ((size_t)br * MP + mtk) * 512 + h * 64 + meg; mv0[br] = *(const u32x4*)src; mv1[br] = *(const u32x4*)(src + 8); }
    const int qi0 = wave * 16, qi = qi0 + fr;
    const bf16x8 bq0 = *(const LAS bf16x8*)(Qs + qi * QS + g * 16), bq1 = *(const LAS bf16x8*)(Qs + qi * QS + 64 + g * 16);
    f32x4 ot[4], xs[4];
#pragma unroll
    for (int et = 0; et < 4; ++et) {
        ot[et] = (f32x4){0.f, 0.f, 0.f, 0.f};
        xs[et] = MFMA16(tr_frag(STt, QS, g * 8, g * 8 + 4, et * 16, fr), bq0, ((f32x4){0.f, 0.f, 0.f, 0.f}));
        xs[et] = MFMA16(tr_frag(STt, QS, 32 + g * 8, 32 + g * 8 + 4, et * 16, fr), bq1, xs[et]);
    }
    const int kt_hi = (qi0 + 15) >> 5;
    for (int kt = 0; kt <= kt_hi; ++kt) {
        f32x4 st[2];
#pragma unroll
        for (int hf = 0; hf < 2; ++hf) {
            ldsp kp = Ks + (kt * 32 + hf * 16 + fr) * QS + g * 16;
            st[hf] = MFMA16(*(const LAS bf16x8*)kp, bq0, ((f32x4){0.f, 0.f, 0.f, 0.f}));
            st[hf] = MFMA16(*(const LAS bf16x8*)(kp + 64), bq1, st[hf]);
        }
        float s[8];
#pragma unroll
        for (int hf = 0; hf < 2; ++hf)
#pragma unroll
            for (int jj = 0; jj < 4; ++jj) { const int dj = qi - (kt * 32 + hf * 16 + 4 * g + jj);
                s[hf * 4 + jj] = dj >= 0 ? st[hf][jj] * 0.125f * ex2(l2g * (float)dj) : 0.f; }
        u32x4 pw; pw.x = pk2(s[0], s[1]); pw.y = pk2(s[2], s[3]); pw.z = pk2(s[4], s[5]); pw.w = pk2(s[6], s[7]);
        const bf16x8 pf = __builtin_bit_cast(bf16x8, pw);
#pragma unroll
        for (int et = 0; et < 4; ++et) {
            ot[et] = MFMA16(tr_frag(VT, QS, kt * 32 + 4 * g, kt * 32 + 16 + 4 * g, et * 16, fr), pf, ot[et]);
        }
    }
    const float qdec = ex2(l2g * (float)(qi + 1));
    float sum = 0.f;
#pragma unroll
    for (int et = 0; et < 4; ++et) { ot[et] = ot[et] + xs[et] * qdec; sum += (ot[et][0] + ot[et][1]) + (ot[et][2] + ot[et][3]); }
    sum += __shfl_xor(sum, 16); sum += __shfl_xor(sum, 32);
    const float mu = sum * (1.f / 64.f); float vsum = 0.f;
#pragma unroll
    for (int et = 0; et < 4; ++et) { ot[et] = ot[et] - mu; vsum += (ot[et][0] * ot[et][0] + ot[et][1] * ot[et][1]) + (ot[et][2] * ot[et][2] + ot[et][3] * ot[et][3]); }
    vsum += __shfl_xor(vsum, 16); vsum += __shfl_xor(vsum, 32);
    const float rstd = __builtin_amdgcn_rsqf(vsum * (1.f / 64.f) + EPS);
    const size_t tok = tok0 + qi;
#pragma unroll
    for (int et = 0; et < 4; ++et) {
        const int ch = h * 64 + et * 16 + 4 * g;
        const f32x4 gw = *(const f32x4*)(a.in[8] + ch), gb = *(const f32x4*)(a.in[9] + ch);
        const u32x2 rgw = *(const u32x2*)(proj + tok * DIN + C_RG + ch);
        const float g0 = __uint_as_float(rgw.x << 16), g1 = __uint_as_float(rgw.x & 0xffff0000u), g2 = __uint_as_float(rgw.y << 16), g3 = __uint_as_float(rgw.y & 0xffff0000u);
        u32x2 w;
        w.x = pk2(silu(g0) * (ot[et][0] * rstd * gw[0] + gb[0]), silu(g1) * (ot[et][1] * rstd * gw[1] + gb[1]));
        w.y = pk2(silu(g2) * (ot[et][2] * rstd * gw[2] + gb[2]), silu(g3) * (ot[et][3] * rstd * gw[3] + gb[3]));
        *(u32x2*)(mix + tok * DM + ch) = w;
    }
    {
        const int eg = meg; const size_t tk = mtk;
        float mm[3], ll[3], M = -INFINITY;
#pragma unroll
        for (int br = 0; br < 3; ++br) { mm[br] = mml[br].x; ll[br] = mml[br].y; M = fmaxf(M, mml[br].x); }
        float wsum = 0.f, wt[3];
#pragma unroll
        for (int br = 0; br < 3; ++br) { wt[br] = ll[br] * ex2(mm[br] - M); wsum += wt[br]; }
        const float winv = __builtin_amdgcn_rcpf(wsum);
        float o[16];
#pragma unroll
        for (int e = 0; e < 16; ++e) o[e] = 0.f;
#pragma unroll
        for (int br = 0; br < 3; ++br) {
            const float w = wt[br] * winv;
            const u32x4 v0 = mv0[br], v1 = mv1[br];
#pragma unroll
            for (int e = 0; e < 4; ++e) { o[2 * e] += w * __uint_as_float(v0[e] << 16); o[2 * e + 1] += w * __uint_as_float(v0[e] & 0xffff0000u);
                                          o[8 + 2 * e] += w * __uint_as_float(v1[e] << 16); o[8 + 2 * e + 1] += w * __uint_as_float(v1[e] & 0xffff0000u); }
        }
        u32x4 w0, w1; w0.x = pk2(o[0], o[1]); w0.y = pk2(o[2], o[3]); w0.z = pk2(o[4], o[5]); w0.w = pk2(o[6], o[7]);
        w1.x = pk2(o[8], o[9]); w1.y = pk2(o[10], o[11]); w1.z = pk2(o[12], o[13]); w1.w = pk2(o[14], o[15]);
        bf16_t* dst = mix + tk * DM + 512 + h * 64 + eg; *(u32x4*)dst = w0; *(u32x4*)(dst + 8) = w1;
    }
}

__device__ __forceinline__ void cache_copy(const Args& a, int lo, int hi, int worker, int nw, int tid) {
    constexpr int PB4 = (WINR - STOK) * 512 / 4;
    const f32x4* ck = (const f32x4*)a.in[3]; const f32x4* cv = (const f32x4*)a.in[4];
    f32x4* ok = (f32x4*)(a.out + O_WKS); f32x4* ov = (f32x4*)(a.out + O_WVS);
    for (int i0 = lo + worker * 2048 + tid; i0 < hi; i0 += nw * 2048) {
        f32x4 kk[4], vv[4]; size_t dd[4];
#pragma unroll
        for (int u = 0; u < 4; ++u) { int i = i0 + u * 512; if (i >= hi) i = hi - 1; const int b = i / PB4, j = i - b * PB4; dd[u] = (size_t)b * (WINR * 128) + j;
            kk[u] = __builtin_nontemporal_load(ck + dd[u] + STOK * 128); vv[u] = __builtin_nontemporal_load(cv + dd[u] + STOK * 128); }
#pragma unroll
        for (int u = 0; u < 4; ++u) { __builtin_nontemporal_store(kk[u], ok + dd[u]); __builtin_nontemporal_store(vv[u], ov + dd[u]); }
    }
}
constexpr int CC_TOT = SBAT * ((WINR - STOK) * 512 / 4), CC_1 = (22 * (CC_TOT / 100)) & ~2047, CC_2 = (40 * (CC_TOT / 100)) & ~2047;
constexpr int P1_COPY_BLOCKS = 28;

__global__ void __launch_bounds__(512, 2) fwd(Args a) {
    extern __shared__ __attribute__((aligned(16))) unsigned char lds_raw[];
    cg::grid_group grid = cg::this_grid();
    ldsp lds = (ldsp)lds_raw;
    const int G = gridDim.x, bx = blockIdx.x;
    volatile LAS unsigned* xbst = (volatile LAS unsigned*)(lds + LDS_BYTES - 16);
    if (threadIdx.x < 4) xbst[threadIdx.x] = 0u;
    __syncthreads();
    const XcdBarrier xbar = xcd_barrier_post((unsigned*)(a.ws + WS_BAR), xbst);
#define PHASE_IDS int tid = threadIdx.x; asm volatile("" : "+v"(tid)); const int lane = tid & 63, wave = __builtin_amdgcn_readfirstlane(tid >> 6); (void)lane; (void)wave;
    unsigned char* ws = a.ws;
    bf16_t* WinT = (bf16_t*)(ws + WS_WIN); bf16_t* WoutT = (bf16_t*)(ws + WS_WOUT); bf16_t* WupT = (bf16_t*)(ws + WS_WUP); bf16_t* WdnT = (bf16_t*)(ws + WS_WDN);
    float* RSQ = (float*)(ws + WS_RSQ); float* RSQ2 = (float*)(ws + WS_RSQ2); bf16_t* H1 = (bf16_t*)(ws + WS_H1); bf16_t* PROJ = (bf16_t*)(ws + WS_PROJ);
    float* U = (float*)(ws + WS_U); bf16_t* SIN = (bf16_t*)(ws + WS_SIN); bf16_t* ATTO = (bf16_t*)(ws + WS_ATTO); float* ATTML = (float*)(ws + WS_ATTML);
    bf16_t* MIX = (bf16_t*)(ws + WS_MIX); float* X1 = (float*)(ws + WS_X1); bf16_t* X1B = (bf16_t*)(ws + WS_X1B); bf16_t* GB = (bf16_t*)(ws + WS_G);

#if !defined(ONLY) || ONLY == 0
    REPS(0)
    {
        PHASE_IDS
        LAS float* scr = (LAS float*)(lds + wave * 16384);
        const int gw = bx * 8 + wave, NGW = G * 8;
        constexpr int I_IN = 16 * 112, I_OUT = 16 * 32, I_UP = 16 * 176, I_DN = 44 * 32, NIT = I_IN + I_OUT + I_UP + I_DN;
        for (int it = gw; it < NIT; it += NGW) {
            int r = it;
            if (r < I_IN) { const int kb = r / 112, nb = r - kb * 112; p0_transpose_item(a.in[7], DM, DIN, WinT, kb * 64, nb * 32, nb * 32, nullptr, scr, lane); continue; } r -= I_IN;
            if (r < I_OUT) { const int kb = r >> 5, nb = r & 31; p0_transpose_item(a.in[10], DM, DM, WoutT, kb * 64, nb * 32, nb * 32, nullptr, scr, lane); continue; } r -= I_OUT;
            if (r < I_UP) { const int kb = r / 176, nb = r - kb * 176; const int n0 = nb * 32; const int mm = n0 < DFF ? n0 : n0 - DFF;
                const int drow = 256 * (mm >> 7) + (mm & 127) + (n0 < DFF ? 0 : 128);
                p0_transpose_item(a.in[12], DM, NUP, WupT, kb * 64, n0, drow, a.in[11], scr, lane); continue; } r -= I_UP;
            { const int kb = r >> 5, nb = r & 31; p0_transpose_item(a.in[15], DFF, DM, WdnT, kb * 64, nb * 32, nb * 32, nullptr, scr, lane); }
        }
        for (int m0 = gw; m0 < MT; m0 += 2 * NGW) {
            const int m1 = m0 + NGW; const bool has1 = m1 < MT; const int m1c = has1 ? m1 : m0;
            const float* xr0 = m0 < MP ? a.in[0] + (size_t)m0 * DM : a.in[1] + (size_t)(m0 - MP) * DM;
            const float* xr1 = m1c < MP ? a.in[0] + (size_t)m1c * DM : a.in[1] + (size_t)(m1c - MP) * DM;
            f32x4 v0[4], v1[4]; float s0 = 0.f, s1 = 0.f;
#pragma unroll
            for (int j = 0; j < 4; ++j) { v0[j] = *(const f32x4*)(xr0 + 4 * lane + 256 * j); v1[j] = *(const f32x4*)(xr1 + 4 * lane + 256 * j); }
#pragma unroll
            for (int j = 0; j < 4; ++j) { s0 += (v0[j][0] * v0[j][0] + v0[j][1] * v0[j][1]) + (v0[j][2] * v0[j][2] + v0[j][3] * v0[j][3]);
                                          s1 += (v1[j][0] * v1[j][0] + v1[j][1] * v1[j][1]) + (v1[j][2] * v1[j][2] + v1[j][3] * v1[j][3]); }
            const float r0 = __builtin_amdgcn_rsqf(wave_sum(s0) * (1.f / DM) + EPS), r1 = __builtin_amdgcn_rsqf(wave_sum(s1) * (1.f / DM) + EPS);
#pragma unroll
            for (int j = 0; j < 4; ++j) { const f32x4 w = *(const f32x4*)(a.in[6] + 4 * lane + 256 * j);
                u32x2 o; o.x = pk2(v0[j][0] * r0 * w[0], v0[j][1] * r0 * w[1]); o.y = pk2(v0[j][2] * r0 * w[2], v0[j][3] * r0 * w[3]);
                *(u32x2*)(H1 + (size_t)m0 * DM + 4 * lane + 256 * j) = o;
                if (has1) { u32x2 p; p.x = pk2(v1[j][0] * r1 * w[0], v1[j][1] * r1 * w[1]); p.y = pk2(v1[j][2] * r1 * w[2], v1[j][3] * r1 * w[3]);
                    *(u32x2*)(H1 + (size_t)m1 * DM + 4 * lane + 256 * j) = p; } }
        }
        const int gt = bx * 512 + tid, NGT = G * 512;
        for (int i = gt; i < MT; i += NGT) { RSQ[i] = 0.f; RSQ2[i] = 0.f; }
        for (int i = gt; i < NB * 2 * DM / 2; i += NGT) { const int b = i / DM, c = i - b * DM; ((unsigned*)(X1B + (size_t)b * X1B_PB * DM))[c] = 0u; }
        if (G < 128) cache_copy(a, 0, CC_1, bx, G, tid);
    }
#endif
    if (a.ws == nullptr) grid.sync();
    xcd_barrier(xbar);
#if !defined(ONLY) || ONLY == 1
    REPS(1)
#if (DBL_MASK) & 512
    for (int r_ = 0; r_ < 8; ++r_) xcd_barrier(xbar);
#endif
    {
        const int Gg = G >= 128 ? G - P1_COPY_BLOCKS : G;
        if (bx < Gg) {
        pg8::StaticOrder S; S.init(MT / 256, DIN / 256, Gg, bx);
        AMapStd AM{(const char*)H1, (size_t)256 * DM * 2, (size_t)128 * DM * 2};
        Epi1 E{PROJ, a.out};
        pg8::gemm_phase(lds, WinT, DM, S, AM, E);
        } else cache_copy(a, 0, CC_1, bx - Gg, G - Gg, threadIdx.x);
    }
#endif
    xcd_barrier(xbar);
#if !defined(ONLY) || ONLY == 2
    REPS(2)
    {
        PHASE_IDS
        constexpr int N_S = SBAT * 8, N_A = 32 * 96, N_U = 1024;
        for (int it = bx; it < N_S; it += G) { sample_item(lds, a, PROJ, MIX, it, tid); if ((DBL_MASK) & 1024) sample_item(lds, a, PROJ, MIX, it, tid); }
        {
            const int vb = (G % 8 == 0) ? (bx % 8) * (G / 8) + bx / 8 : bx;
            AttnRegs R; const int it_lo = (int)((long)vb * N_A / G), it_hi = (int)((long)(vb + 1) * N_A / G);
            int it = it_lo;
            bool nl = (it < it_hi) && (attn_decode(it).i0 != 0);
            if (it < it_hi) attn_load(R, PROJ, it, tid, nl);
            while (it < it_hi) {
                const int parity = (it - it_lo) & 1;
                __syncthreads();
                attn_store(lds, R, tid, parity, nl);
                __syncthreads();
                const int nx = it + 1;
                nl = false;
                if (nx < it_hi) attn_load(R, PROJ, nx, tid, false);
                attn_compute(lds, ATTO, ATTML, it, tid, parity);
                it = nx;
            }
        }
        for (int it = bx; it < N_U; it += G) ret_local_item(lds, PROJ, U, it, tid);
    }
#endif
    xcd_barrier(xbar);
#if !defined(ONLY) || ONLY == 3
    REPS(3)
    {
        PHASE_IDS
        for (int idx = bx * 512 + tid; idx < NB * 8 * 4096; idx += G * 512) {
            const int bh = idx >> 12, el = idx & 4095, h = bh & 7;
            const float g128 = ex2(lgam(h) * 128.f);
            float s = 0.f, uv[32];
#pragma unroll
            for (int c = 0; c < 32; ++c) uv[c] = U[((size_t)bh * 32 + c) * 4096 + el];
#pragma unroll
            for (int c = 0; c < 32; ++c) { SIN[((size_t)bh * 32 + c) * 4096 + el] = f2bf(s); s = s * g128 + uv[c]; }
            a.out[O_RETP + idx] = s;
        }
    }
#endif
    xcd_barrier(xbar);
#if !defined(ONLY) || ONLY == 4
    REPS(4)
    { PHASE_IDS
    RetRegs R; int it = bx;
    if (it < 1024) ret_load(R, PROJ, SIN, it, tid);
    while (it < 1024) {
        __syncthreads();
        ret_store(lds, R, tid);
        __syncthreads();
        const int nx = it + G;
        if (nx < 1024) ret_load(R, PROJ, SIN, nx, tid);
        ret_compute(lds, a, PROJ, ATTO, ATTML, MIX, it, tid);
        it = nx;
    }
    __syncthreads(); }
#endif
    xcd_barrier(xbar);
#if !defined(ONLY) || ONLY == 5
    REPS(5)
    {
        pg8::StaticOrder S; S.init(MT / 256, DM / 256, G, bx);
        AMapStd AM{(const char*)MIX, (size_t)256 * DM * 2, (size_t)128 * DM * 2};
        Epi5 E{a.in[0], a.in[1], X1, X1B, RSQ, rep_ == 0};
        pg8::gemm_phase(lds, WoutT, DM, S, AM, E);
        if (bx >= 4) cache_copy(a, CC_1, CC_2, bx - 4, G - 4, threadIdx.x);
    }
#endif
    xcd_barrier(xbar);
#if !defined(ONLY) || ONLY == 6
    REPS(6)
    {
        pg8::StaticOrder S; S.init(69, NUP / 256, G, bx);
        AMapUp AM{(const char*)X1B};
        Epi6 E{RSQ, a.in[13], a.in[14], a.in[5], GB, a.out};
        pg8::gemm_phase(lds, WupT, DM, S, AM, E);
    }
#endif
    xcd_barrier(xbar);
#if !defined(ONLY) || ONLY == 7
    {
        pg8::StaticOrder S; S.init(MT / 256, DM / 256, G, bx);
        AMapStd AM{(const char*)GB, (size_t)256 * DFF * 2, (size_t)128 * DFF * 2};
        Epi7 E{X1B, a.out + O_Y, RSQ2, (unsigned*)(ws + WS_CNT), a.in[16], &a, bx - 4, bx >= 4 ? G - 4 : 0, CC_2, CC_TOT};
        pg8::gemm_phase(lds, WdnT, DFF, S, AM, E);
    }
#endif
}

extern "C" void kernel_launch(void* const* d_in, const int* in_sizes, int n_in, void* d_out, int out_size, void* d_ws, size_t ws_size, hipStream_t stream) {
    static int grid_blocks = 0;
    if (grid_blocks == 0) {
        if (n_in != 17 || ws_size < WS_END) { fprintf(stderr, "kernel_launch: unexpected n_in %d / ws %zu\n", n_in, ws_size); grid_blocks = -1; return; }
        int dev = 0, cus = 0, per_cu = 0;
        hipGetDevice(&dev);
        hipDeviceGetAttribute(&cus, hipDeviceAttributeMultiprocessorCount, dev);
        if (hipFuncSetAttribute((const void*)fwd, hipFuncAttributeMaxDynamicSharedMemorySize, LDS_BYTES) != hipSuccess) { fprintf(stderr, "kernel_launch: hipFuncSetAttribute failed\n"); grid_blocks = -1; return; }
        if (hipOccupancyMaxActiveBlocksPerMultiprocessor(&per_cu, (const void*)fwd, 512, LDS_BYTES) != hipSuccess || per_cu < 1) { fprintf(stderr, "kernel_launch: occupancy query gives %d\n", per_cu); (void)hipGetLastError(); per_cu = 1; }
        grid_blocks = cus * per_cu;
    }
    if (grid_blocks < 0) return;
    if (hipMemsetAsync((char*)d_ws + WS_BAR, 0, BAR_ZERO_BYTES, stream) != hipSuccess) { fprintf(stderr, "kernel_launch: memset failed\n"); return; }
    Args a{};
    for (int i = 0; i < 17; ++i) a.in[i] = (const float*)d_in[i];
    a.out = (float*)d_out; a.ws = (unsigned char*)d_ws;
    void* args[] = {&a};
    hipError_t e = hipLaunchCooperativeKernel((const void*)fwd, dim3(grid_blocks), dim3(512), args, LDS_BYTES, stream);
    if (e != hipSuccess) fprintf(stderr, "cooperative launch failed: %s (grid %d)\n", hipGetErrorString(e), grid_blocks);
}
```

```cpp
#include <hip/hip_runtime.h>
#include <hip/hip_cooperative_groups.h>
#include <cstdio>
#include <cstdint>
namespace cg = cooperative_groups;

#define LAS __attribute__((address_space(3)))
typedef unsigned short bf16_t;
typedef short bf16x8 __attribute__((ext_vector_type(8)));
typedef short s16x4 __attribute__((ext_vector_type(4)));
typedef float f32x4 __attribute__((ext_vector_type(4)));
typedef float f32x2 __attribute__((ext_vector_type(2)));
typedef unsigned u32x4 __attribute__((ext_vector_type(4)));
typedef unsigned u32x2 __attribute__((ext_vector_type(2)));
typedef __bf16 bf16x2_t __attribute__((ext_vector_type(2)));
typedef LAS unsigned char* ldsp;

constexpr int DM = 1024, NB = 4, SEQ = 4096, MP = NB * SEQ, SBAT = 32, STOK = 8, MS = SBAT * STOK, MT = MP + MS;
constexpr int DIN = 3584, DFF = 2816, NUP = 2 * DFF;
constexpr int C_RQ = 0, C_RK = 512, C_RV = 1024, C_RG = 1536, C_AQ = 2048, C_AK = 2560, C_AV = 3072;
constexpr int WINR = 2048;
constexpr float EPS = 1e-6f, LOG2E = 1.4426950408889634f;
constexpr size_t O_Y = 0, O_RETP = 17039360, O_RETS = 17170432, O_WKP = 18219008, O_WVP = 22413312, O_WKS = 26607616, O_WVS = 60162048,
                 O_CVP = 93716480, O_CVS = 93739008;
constexpr size_t MiB = 1u << 20;
constexpr size_t WS_WIN = 0, WS_WOUT = 8 * MiB, WS_WUP = 10 * MiB, WS_WDN = 22 * MiB, WS_RSQ = 28 * MiB, WS_H1 = 32 * MiB, WS_PROJ = 66 * MiB,
                 WS_U = 180 * MiB, WS_SIN = 196 * MiB, WS_ATTO = 204 * MiB, WS_ATTML = 252 * MiB, WS_MIX = 256 * MiB, WS_X1 = 290 * MiB,
                 WS_X1B = 356 * MiB, WS_G = 392 * MiB, WS_END = 484 * MiB;
constexpr size_t WS_BAR = 30 * MiB, WS_CNT = WS_BAR + 16384, BAR_ZERO_BYTES = 16384 + 65 * 256, WS_RSQ2 = WS_RSQ + 128 * 1024;
constexpr int X1B_PB = 4216, X1B_SROW = 16872;
constexpr int LDS_BYTES = 147456;
#ifndef DBL_MASK
#define DBL_MASK 0
#endif
#define REPS(k) for (int rep_ = 0; rep_ < (((DBL_MASK) >> (k)) & 1) + 1; ++rep_)

__device__ __forceinline__ float bf2f(bf16_t b) { return __uint_as_float((unsigned)b << 16); }
__device__ __forceinline__ unsigned pk2(float lo, float hi) { f32x2 v = {lo, hi}; bf16x2_t b = __builtin_convertvector(v, bf16x2_t); return __builtin_bit_cast(unsigned, b); }
__device__ __forceinline__ bf16_t f2bf(float f) { return (bf16_t)(pk2(f, 0.f) & 0xffffu); }
__device__ __forceinline__ float ex2(float x) { return __builtin_amdgcn_exp2f(x); }
__device__ __forceinline__ float silu(float x) { return x * __builtin_amdgcn_rcpf(1.f + ex2(-x * LOG2E)); }
__device__ __forceinline__ float wave_sum(float v) {
#pragma unroll
    for (int o = 1; o < 64; o <<= 1) v += __shfl_xor(v, o);
    return v;
}
__device__ __forceinline__ float wave_max(float v) {
#pragma unroll
    for (int o = 1; o < 64; o <<= 1) v = fmaxf(v, __shfl_xor(v, o));
    return v;
}
#define MFMA16(a, b, c) __builtin_amdgcn_mfma_f32_16x16x32_bf16((a), (b), (c), 0, 0, 0)
typedef short v4i16_t __attribute__((ext_vector_type(4)));
__device__ __forceinline__ s16x4 lds_tr4(ldsp p) { return __builtin_bit_cast(s16x4, __builtin_amdgcn_ds_read_tr16_b64_v4i16((LAS v4i16_t*)p)); }
__device__ __forceinline__ bf16x8 tr_frag(ldsp img, int stride, int r0, int r1, int c0, int fr) {
    const int q = fr >> 2, p = fr & 3;
    const s16x4 lo = lds_tr4(img + (r0 + q) * stride + (c0 + 4 * p) * 2), hi = lds_tr4(img + (r1 + q) * stride + (c0 + 4 * p) * 2);
    return __builtin_shufflevector(lo, hi, 0, 1, 2, 3, 4, 5, 6, 7);
}

namespace pg8 {
constexpr int BM = 256, BK = 64, HALF = 128, HTB = HALF * BK * 2, STAGE_BYTES = 8 * HTB, NXCD = 8, WGM = 8;
__host__ __device__ __forceinline__ int lds_byte(int r, int c) { const int st = (r >> 4) * 2 + (c >> 5), rr = r & 15, cc = c & 31, ob = rr * 64 + cc * 2; return st * 1024 + (ob ^ (((ob >> 9) & 1) << 5)); }
__host__ __device__ __forceinline__ void stage_rc(int b, int& R, int& C) { const int st = b / 1024, sb = b % 1024, swz = sb ^ (((sb >> 9) & 1) << 5); R = (st >> 1) * 16 + swz / 64; C = (st & 1) * 32 + (swz % 64) / 2; }
__host__ __device__ __forceinline__ int perm32(int rho) { const int n = rho >> 4, i = rho & 15; return 8 * (i >> 2) + 4 * n + (i & 3); }
struct Unit { int pm, pn; };
struct ADesc { const char* base; size_t hstep; unsigned delta; };
struct StaticOrder {
    int nM, nN, nwg, G, c;
    __device__ void init(int nM_, int nN_, int G_, int c_) { nM = nM_; nN = nN_; nwg = nM * nN; G = G_; c = c_; }
    __device__ bool next(int i, Unit& u) const {
        const long L = (long)i * G + c; if (L >= nwg) return false;
        int wgid = (int)L; { const int q = nwg / NXCD, r = nwg % NXCD, xcd = wgid % NXCD, off = wgid / NXCD; wgid = (xcd < r ? xcd * (q + 1) : r * (q + 1) + (xcd - r) * q) + off; }
        const int nig = WGM * nN, gid = wgid / nig, fm = gid * WGM, gsz = (nM - fm) < WGM ? (nM - fm) : WGM;
        u.pm = fm + ((wgid % nig) % gsz); u.pn = (wgid % nig) / gsz; return true;
    }
};
template <class Epi, class AMap>
__device__ __forceinline__ void gemm_phase(ldsp lds, const bf16_t* Bt, int K, const StaticOrder& S, const AMap& AM, const Epi& E) {
    int tid_ = threadIdx.x; asm volatile("" : "+v"(tid_));
    const int tid = tid_, wid = __builtin_amdgcn_readfirstlane(tid >> 6), lane = tid & 63, wr = wid >> 2, wc = wid & 3, fr = lane & 15, fq = lane >> 4;
    const int nt = K / BK;
    unsigned voffA[2], voffB[2];
#pragma unroll
    for (int i = 0; i < 2; ++i) { int R, C; stage_rc(tid * 16 + i * 8192, R, C); const int Rb = (R & ~31) + perm32(R & 31);
        voffA[i] = (unsigned)(R * K + C) * 2u; voffB[i] = (unsigned)(Rb * K + C) * 2u; }
    const size_t kstep = (size_t)(BK * 2);
    const size_t hstepB = (size_t)HALF * K * 2;
    const size_t tstepB = 2 * hstepB;
    const unsigned ldsw = (unsigned)wid * 1024u;
    const int aoff = lds_byte(wr * 64 + fr, fq * 8), boff = lds_byte(wc * 32 + fr, fq * 8);
#define PG8_SA(b, h) (((b) * 2 + (h)) * HTB)
#define PG8_SB(b, h) ((4 + (b) * 2 + (h)) * HTB)
#define PG8_STAGEB(bufoff, gbase) do { _Pragma("unroll") for (int _i = 0; _i < 2; ++_i) \
        __builtin_amdgcn_global_load_lds((const unsigned*)((const char*)(gbase) + voffB[_i]), (LAS unsigned*)(lds + (bufoff) + ldsw + _i * 8192), 16, 0, 0); } while (0)
#define PG8_STAGEA(bufoff, gbase, dlt) do { _Pragma("unroll") for (int _i = 0; _i < 2; ++_i) \
        __builtin_amdgcn_global_load_lds((const unsigned*)((const char*)(gbase) + voffA[_i] - (size_t)(_i * (dlt))), (LAS unsigned*)(lds + (bufoff) + ldsw + _i * 8192), 16, 0, 0); } while (0)
#define PG8_LDA(dst, b, h) do { _Pragma("unroll") for (int m = 0; m < 4; ++m) _Pragma("unroll") for (int k = 0; k < 2; ++k) dst[m][k] = *(const LAS bf16x8*)(lds + PG8_SA(b, h) + aoff + m * 2048 + k * 1024); } while (0)
#define PG8_LDB(dst, b, h) do { _Pragma("unroll") for (int n = 0; n < 2; ++n) _Pragma("unroll") for (int k = 0; k < 2; ++k) dst[n][k] = *(const LAS bf16x8*)(lds + PG8_SB(b, h) + boff + n * 2048 + k * 1024); } while (0)
#define PG8_MMA(ai, bj, At, Bt_) do { __builtin_amdgcn_s_setprio(1); _Pragma("unroll") for (int m = 0; m < 4; ++m) _Pragma("unroll") for (int n = 0; n < 2; ++n) _Pragma("unroll") for (int k = 0; k < 2; ++k) \
        acc[ai][bj][m][n] = __builtin_amdgcn_mfma_f32_16x16x32_bf16(Bt_[n][k], At[m][k], acc[ai][bj][m][n], 0, 0, 0); __builtin_amdgcn_s_setprio(0); } while (0)
#define PG8_WAIT_V(n) asm volatile("s_waitcnt vmcnt(" #n ")" ::: "memory")
#define PG8_WAIT_L(n) asm volatile("s_waitcnt lgkmcnt(" #n ")" ::: "memory")
#define PG8_BAR __builtin_amdgcn_s_barrier()
#define PG8_SCHED __builtin_amdgcn_sched_barrier(0)
    Unit cur, nxt; int ui = 0;
    if (!S.next(0, cur)) return;
    f32x4 acc[2][2][4][2];
#pragma unroll
    for (int a = 0; a < 2; ++a)
#pragma unroll
        for (int b = 0; b < 2; ++b)
#pragma unroll
            for (int m = 0; m < 4; ++m)
#pragma unroll
                for (int n = 0; n < 2; ++n) acc[a][b][m][n] = (f32x4){0.f, 0.f, 0.f, 0.f};
    bf16x8 At[4][2], B0[2][2], B1[2][2];
    ADesc cd = AM(cur);
    const char* cA = cd.base; size_t cH = cd.hstep; unsigned cD = cd.delta;
    const char* cB = (const char*)Bt + (size_t)cur.pn * tstepB;
    PG8_STAGEB(PG8_SB(0, 0), cB); PG8_STAGEB(PG8_SB(0, 1), cB + hstepB); PG8_STAGEA(PG8_SA(0, 0), cA, cD); PG8_STAGEA(PG8_SA(0, 1), cA + cH, cD);
    if (wr == 1) PG8_BAR;
    PG8_WAIT_V(2); PG8_BAR;
    PG8_STAGEB(PG8_SB(1, 0), cB + kstep); PG8_STAGEA(PG8_SA(1, 0), cA + kstep, cD); PG8_STAGEB(PG8_SB(1, 1), cB + hstepB + kstep);
    PG8_WAIT_V(6); PG8_BAR;
    for (;;) {
        const bool has_next = S.next(ui + 1, nxt);
        ADesc nd = cd; if (has_next) nd = AM(nxt);
        const char* nA = nd.base; const size_t nH = nd.hstep; const unsigned nD = nd.delta;
        const char* nB = has_next ? (const char*)Bt + (size_t)nxt.pn * tstepB : cB;
        for (int t = 0; t < nt; t += 2) {
            const bool last = (t == nt - 2);
            const char* a1 = cA + (size_t)(t + 1) * kstep;
            const char* a2 = last ? nA : cA + (size_t)(t + 2) * kstep; const char* b2 = last ? nB : cB + (size_t)(t + 2) * kstep;
            const char* a3 = a2 + kstep; const char* b3 = b2 + kstep;
            const size_t h2 = last ? nH : cH; const unsigned d2 = last ? nD : cD;
            PG8_LDB(B0, 0, 0); PG8_LDB(B1, 0, 1); PG8_SCHED; PG8_LDA(At, 0, 0); PG8_STAGEA(PG8_SA(1, 1), a1 + cH, cD);
            PG8_WAIT_V(8); PG8_WAIT_L(0); PG8_BAR; PG8_MMA(0, 0, At, B0); PG8_MMA(0, 1, At, B1); PG8_BAR; PG8_SCHED;
            PG8_LDA(At, 0, 1); PG8_STAGEB(PG8_SB(0, 0), b2); PG8_STAGEB(PG8_SB(0, 1), b2 + hstepB); PG8_STAGEA(PG8_SA(0, 0), a2, d2);
            PG8_WAIT_V(8); PG8_WAIT_L(0); PG8_BAR; PG8_MMA(1, 0, At, B0); PG8_MMA(1, 1, At, B1); PG8_BAR; PG8_SCHED;
            PG8_LDB(B0, 1, 0); PG8_LDB(B1, 1, 1); PG8_SCHED; PG8_LDA(At, 1, 0); PG8_STAGEA(PG8_SA(0, 1), a2 + h2, d2);
            PG8_WAIT_V(8); PG8_WAIT_L(0); PG8_BAR; PG8_MMA(0, 0, At, B0); PG8_MMA(0, 1, At, B1); PG8_BAR; PG8_SCHED;
            PG8_LDA(At, 1, 1); PG8_STAGEB(PG8_SB(1, 0), b3); PG8_STAGEB(PG8_SB(1, 1), b3 + hstepB); PG8_STAGEA(PG8_SA(1, 0), a3, d2);
            PG8_WAIT_V(8); PG8_WAIT_L(0); PG8_BAR; PG8_MMA(1, 0, At, B0); PG8_MMA(1, 1, At, B1); PG8_BAR; PG8_SCHED;
        }
        if (wr == 0) PG8_BAR;
        E(acc, cur, wr, wc, fr, fq);
        if (!has_next) break;
#pragma unroll
        for (int a = 0; a < 2; ++a)
#pragma unroll
            for (int b = 0; b < 2; ++b)
#pragma unroll
                for (int m = 0; m < 4; ++m)
#pragma unroll
                    for (int n = 0; n < 2; ++n) acc[a][b][m][n] = (f32x4){0.f, 0.f, 0.f, 0.f};
        cur = nxt; cA = nA; cB = nB; cH = nH; cD = nD; cd = nd; ++ui;
        if (wr == 1) PG8_BAR;
    }
    PG8_WAIT_V(0);
    PG8_BAR;
#undef PG8_SA
#undef PG8_SB
#undef PG8_STAGEA
#undef PG8_STAGEB
#undef PG8_LDA
#undef PG8_LDB
#undef PG8_MMA
#undef PG8_WAIT_V
#undef PG8_WAIT_L
#undef PG8_BAR
#undef PG8_SCHED
}
}
using pg8::Unit; using pg8::ADesc;
typedef f32x4 Acc[2][2][4][2];

struct AMapStd { const char* A; size_t tstep, hstep; __device__ __forceinline__ ADesc operator()(const Unit& u) const { return ADesc{A + (size_t)u.pm * tstep, hstep, 0u}; } };
struct AMapUp {
    const char* A;
    __device__ __forceinline__ ADesc operator()(const Unit& u) const {
        if (u.pm < 68) return ADesc{A + (size_t)u.pm * 248 * DM * 2, (size_t)124 * DM * 2, 2u * DM * 2u};
        return ADesc{A + (size_t)X1B_SROW * DM * 2, (size_t)128 * DM * 2, 0u};
    }
};

struct Epi1 {
    bf16_t* proj; float* out;
    __device__ __forceinline__ void operator()(const Acc& acc, const Unit& u, int wr, int wc, int fr_, int fq_) const {
        int fr = fr_, fq = fq_; asm volatile("" : "+v"(fr), "+v"(fq));
        const int colb = u.pn * 256 + wc * 32 + 8 * fq;
#pragma unroll
        for (int ai = 0; ai < 2; ++ai)
#pragma unroll
            for (int m = 0; m < 4; ++m) {
                const int row = u.pm * 256 + ai * 128 + wr * 64 + m * 16 + fr;
                float* wrow = nullptr;
                if (u.pn >= 10) {
                    const bool isv = u.pn >= 12;
                    if (row < MP) { const int b = row >> 12, t = row & 4095; if (t >= SEQ - WINR) wrow = out + (isv ? O_WVP : O_WKP) + ((size_t)b * WINR + (t - (SEQ - WINR))) * 512; }
                    else { const int s = row - MP, b = s >> 3, i = s & 7; wrow = out + (isv ? O_WVS : O_WKS) + ((size_t)b * WINR + (WINR - STOK + i)) * 512; }
                }
#pragma unroll
                for (int bj = 0; bj < 2; ++bj) {
                    const f32x4 v0 = acc[ai][bj][m][0], v1 = acc[ai][bj][m][1];
                    const int col = colb + bj * 128;
                    u32x4 w; w.x = pk2(v0[0], v0[1]); w.y = pk2(v0[2], v0[3]); w.z = pk2(v1[0], v1[1]); w.w = pk2(v1[2], v1[3]);
                    *(u32x4*)(proj + (size_t)row * DIN + col) = w;
                    if (wrow) { const int c = (col - C_AK) & 511; *(f32x4*)(wrow + c) = v0; *(f32x4*)(wrow + c + 4) = v1; }
                }
            }
    }
};
struct Epi5 {
    const float* xp; const float* xs; float* x1; bf16_t* x1b; float* rsq; int do_rsq;
    __device__ __forceinline__ void operator()(const Acc& acc, const Unit& u, int wr, int wc, int fr_, int fq_) const {
        int fr = fr_, fq = fq_; asm volatile("" : "+v"(fr), "+v"(fq));
        const int colb = u.pn * 256 + wc * 32 + 8 * fq;
#pragma unroll
        for (int ai = 0; ai < 2; ++ai) {
            f32x4 xv[4][2][2];
#pragma unroll
            for (int m = 0; m < 4; ++m) {
                const int row = u.pm * 256 + ai * 128 + wr * 64 + m * 16 + fr;
                const float* xrow = row < MP ? xp + (size_t)row * DM : xs + (size_t)(row - MP) * DM;
#pragma unroll
                for (int bj = 0; bj < 2; ++bj) { xv[m][bj][0] = *(const f32x4*)(xrow + colb + bj * 128); xv[m][bj][1] = *(const f32x4*)(xrow + colb + bj * 128 + 4); }
            }
#pragma unroll
            for (int m = 0; m < 4; ++m) {
                const int row = u.pm * 256 + ai * 128 + wr * 64 + m * 16 + fr;
                const int brow = row < MP ? (row >> 12) * X1B_PB + 2 + (row & 4095) : X1B_SROW + (row - MP);
                float ss = 0.f;
#pragma unroll
                for (int bj = 0; bj < 2; ++bj) {
                    const int col = colb + bj * 128;
                    const f32x4 v0 = acc[ai][bj][m][0] + xv[m][bj][0], v1 = acc[ai][bj][m][1] + xv[m][bj][1];
                    u32x4 w; w.x = pk2(v0[0], v0[1]); w.y = pk2(v0[2], v0[3]); w.z = pk2(v1[0], v1[1]); w.w = pk2(v1[2], v1[3]);
                    *(u32x4*)(x1b + (size_t)brow * DM + col) = w;
                    ss += (v0[0] * v0[0] + v0[1] * v0[1]) + (v0[2] * v0[2] + v0[3] * v0[3]) + (v1[0] * v1[0] + v1[1] * v1[1]) + (v1[2] * v1[2] + v1[3] * v1[3]);
                }
                ss += __shfl_xor(ss, 16); ss += __shfl_xor(ss, 32);
                if (fq == 0 && do_rsq) unsafeAtomicAdd(rsq + row, ss);
            }
        }
    }
};
struct Epi6 {
    const float* rsq; const float* cw; const float* cb; const float* sconv; bf16_t* g; float* out;
    __device__ __forceinline__ void operator()(const Acc& acc, const Unit& u, int wr, int wc, int fr_, int fq_) const {
        int fr = fr_, fq = fq_; asm volatile("" : "+v"(fr), "+v"(fq));
        const bool samp = (u.pm >= 68);
        const int pb = u.pm / 17, pi = u.pm - pb * 17;
        float rstd8[2][4];
#pragma unroll
        for (int ai = 0; ai < 2; ++ai)
#pragma unroll
            for (int m = 0; m < 4; ++m) {
                const int q = ai * 2 + wr, lr = m * 16 + fr; int tok;
                if (!samp) { const int p = pi * 248 + q * 62 + lr - 2; const int pc = p < 0 ? 0 : (p >= SEQ ? SEQ - 1 : p); tok = pb * SEQ + pc; }
                else tok = MP + q * 64 + lr;
                rstd8[ai][m] = rsq[tok];
            }
#pragma unroll
        for (int ai = 0; ai < 2; ++ai)
#pragma unroll
            for (int m = 0; m < 4; ++m) rstd8[ai][m] = __builtin_amdgcn_rsqf(rstd8[ai][m] * (1.0f / DM) + EPS);
        const int c0 = u.pn * 128 + wc * 32 + 8 * fq;
        f32x4 w0[2], w1[2], w2[2], bb[2];
#pragma unroll
        for (int n = 0; n < 2; ++n) { w0[n] = *(const f32x4*)(cw + c0 + 4 * n); w1[n] = *(const f32x4*)(cw + DFF + c0 + 4 * n); w2[n] = *(const f32x4*)(cw + 2 * DFF + c0 + 4 * n); bb[n] = *(const f32x4*)(cb + c0 + 4 * n); }
#pragma unroll
        for (int ai = 0; ai < 2; ++ai) {
            const int q = ai * 2 + wr;
            f32x4 pr1[2], pr2[2];
#pragma unroll
            for (int n = 0; n < 2; ++n) { pr1[n] = (f32x4){0.f, 0.f, 0.f, 0.f}; pr2[n] = (f32x4){0.f, 0.f, 0.f, 0.f}; }
#pragma unroll
            for (int m = 0; m < 4; ++m) {
                const int lr = m * 16 + fr;
                int tok, p = 0, sb = 0, stt = 0; bool valid;
                if (!samp) { p = pi * 248 + q * 62 + lr - 2; valid = (lr >= 2) && (p < SEQ); const int pc = p < 0 ? 0 : (p >= SEQ ? SEQ - 1 : p); tok = pb * SEQ + pc; }
                else { const int s = q * 64 + lr; sb = s >> 3; stt = s & 7; tok = MP + s; valid = true; }
                const float rstd = rstd8[ai][m];
                u32x4 wout; f32x4 uas[2];
#pragma unroll
                for (int n = 0; n < 2; ++n) {
                    const f32x4 ua = acc[ai][0][m][n] * rstd, ub = acc[ai][1][m][n] * rstd;
                    f32x4 r1, r2, o, p1, p2;
#pragma unroll
                    for (int e = 0; e < 4; ++e) { const float uae = ua[e]; const int uai = __float_as_int(uae);
                        r1[e] = __int_as_float(__builtin_amdgcn_update_dpp(0, uai, 0x121, 0xf, 0xf, false));
                        r2[e] = __int_as_float(__builtin_amdgcn_update_dpp(0, uai, 0x122, 0xf, 0xf, false)); }
                    if (!samp) {
#pragma unroll
                        for (int e = 0; e < 4; ++e) { p1[e] = fr >= 1 ? r1[e] : pr1[n][e]; p2[e] = fr >= 2 ? r2[e] : pr2[n][e]; }
                    } else {
                        const float* s0 = sconv + (size_t)sb * 2 * DFF + c0 + 4 * n;
                        const f32x4 sa = *(const f32x4*)s0, sbv = *(const f32x4*)(s0 + DFF);
#pragma unroll
                        for (int e = 0; e < 4; ++e) { p1[e] = stt >= 1 ? r1[e] : sbv[e]; p2[e] = stt >= 2 ? r2[e] : (stt == 1 ? sbv[e] : sa[e]); }
                    }
#pragma unroll
                    for (int e = 0; e < 4; ++e) { const float cv = bb[n][e] + w0[n][e] * p2[e] + w1[n][e] * p1[e] + w2[n][e] * ua[e]; o[e] = silu(cv) * ub[e]; }
                    pr1[n] = r1; pr2[n] = r2; uas[n] = ua;
                    if (n == 0) { wout.x = pk2(o[0], o[1]); wout.y = pk2(o[2], o[3]); } else { wout.z = pk2(o[0], o[1]); wout.w = pk2(o[2], o[3]); }
                }
                if (valid) {
                    *(u32x4*)(g + (size_t)tok * DFF + c0) = wout;
                    float* so = nullptr;
                    if (!samp) { if (p >= SEQ - 2) so = out + O_CVP + ((size_t)pb * 2 + (p - (SEQ - 2))) * DFF + c0; }
                    else { if (stt >= 6) so = out + O_CVS + ((size_t)sb * 2 + (stt - 6)) * DFF + c0; }
                    if (so) { *(f32x4*)so = uas[0]; *(f32x4*)(so + 4) = uas[1]; }
                }
            }
        }
    }
};
struct Args;
__device__ __forceinline__ void cache_copy(const Args& a, int lo, int hi, int worker, int nw, int tid);
struct Epi7 {
    const bf16_t* x1b; float* y; float* rsq2; unsigned* cnt; const float* wf; const Args* args; int copy_worker, copy_nw, copy_lo, copy_hi;
    __device__ __forceinline__ void operator()(Acc& acc, const Unit& u, int wr, int wc, int fr_, int fq_) const {
        int fr = fr_, fq = fq_; asm volatile("" : "+v"(fr), "+v"(fq));
        const int colb = u.pn * 256 + wc * 32 + 8 * fq;
        u32x4 rv[2][4][2];
#pragma unroll
        for (int ai = 0; ai < 2; ++ai)
#pragma unroll
            for (int m = 0; m < 4; ++m) {
                const int row = u.pm * 256 + ai * 128 + wr * 64 + m * 16 + fr;
                const int brow = row < MP ? (row >> 12) * X1B_PB + 2 + (row & 4095) : X1B_SROW + (row - MP);
#pragma unroll
                for (int bj = 0; bj < 2; ++bj) rv[ai][m][bj] = *(const u32x4*)(x1b + (size_t)brow * DM + colb + bj * 128);
            }
#pragma unroll
        for (int ai = 0; ai < 2; ++ai)
#pragma unroll
            for (int m = 0; m < 4; ++m) {
                const int row = u.pm * 256 + ai * 128 + wr * 64 + m * 16 + fr;
                float ss = 0.f;
#pragma unroll
                for (int bj = 0; bj < 2; ++bj) {
                    const u32x4 r = rv[ai][m][bj];
                    const f32x4 r0 = {__uint_as_float(r.x << 16), __uint_as_float(r.x & 0xffff0000u), __uint_as_float(r.y << 16), __uint_as_float(r.y & 0xffff0000u)};
                    const f32x4 r1 = {__uint_as_float(r.z << 16), __uint_as_float(r.z & 0xffff0000u), __uint_as_float(r.w << 16), __uint_as_float(r.w & 0xffff0000u)};
                    const f32x4 v0 = acc[ai][bj][m][0] + r0, v1 = acc[ai][bj][m][1] + r1;
                    acc[ai][bj][m][0] = v0; acc[ai][bj][m][1] = v1;
                    ss += (v0[0] * v0[0] + v0[1] * v0[1]) + (v0[2] * v0[2] + v0[3] * v0[3]) + (v1[0] * v1[0] + v1[1] * v1[1]) + (v1[2] * v1[2] + v1[3] * v1[3]);
                }
                ss += __shfl_xor(ss, 16); ss += __shfl_xor(ss, 32);
                if (fq == 0) unsafeAtomicAdd(rsq2 + row, ss);
            }
        asm volatile("s_waitcnt vmcnt(0)" ::: "memory");
        unsigned* pc = cnt + 64 * u.pm;
        if ((threadIdx.x & 63) == 0) __hip_atomic_fetch_add(pc, 1u, __ATOMIC_RELAXED, __HIP_MEMORY_SCOPE_AGENT);
        if (copy_nw > 0) cache_copy(*args, copy_lo, copy_hi, copy_worker, copy_nw, threadIdx.x);
        {
            unsigned sp = 0;
            while (__hip_atomic_load(pc, __ATOMIC_RELAXED, __HIP_MEMORY_SCOPE_AGENT) < 32u) { __builtin_amdgcn_s_sleep(4); if (++sp > (1u << 22)) break; }
            asm volatile("" ::: "memory");
        }
        f32x4 wv[2][2];
#pragma unroll
        for (int bj = 0; bj < 2; ++bj) { wv[bj][0] = *(const f32x4*)(wf + colb + bj * 128); wv[bj][1] = *(const f32x4*)(wf + colb + bj * 128 + 4); }
#pragma unroll
        for (int ai = 0; ai < 2; ++ai)
#pragma unroll
            for (int m = 0; m < 4; ++m) {
                const int row = u.pm * 256 + ai * 128 + wr * 64 + m * 16 + fr;
                const float rstd = __builtin_amdgcn_rsqf(__hip_atomic_load(rsq2 + row, __ATOMIC_RELAXED, __HIP_MEMORY_SCOPE_AGENT) * (1.0f / DM) + EPS);
                const size_t ro = (size_t)row * DM;
#pragma unroll
                for (int bj = 0; bj < 2; ++bj) {
                    const int col = colb + bj * 128;
                    *(f32x4*)(y + ro + col) = acc[ai][bj][m][0] * rstd * wv[bj][0];
                    *(f32x4*)(y + ro + col + 4) = acc[ai][bj][m][1] * rstd * wv[bj][1];
                }
            }
    }
};

#define XB_TMO      128
#define XB_XCNT(j)  (256  + 64 * (j))
#define XB_XSUB(j)  (1280 + 64 * (j))
#define XB_XGEN(j)  (2304 + 64 * (j))
#define XB_TOP      3328
#define XB_TOPGEN   3392
#define XCD_BAR_WORDS 3456
#define XB_SPIN_CAP (1u << 20)
__device__ __forceinline__ unsigned xb_ld(unsigned* p)              { return __hip_atomic_load(p, __ATOMIC_RELAXED, __HIP_MEMORY_SCOPE_AGENT); }
__device__ __forceinline__ unsigned xb_add(unsigned* p, unsigned v) { return __hip_atomic_fetch_add(p, v, __ATOMIC_RELAXED, __HIP_MEMORY_SCOPE_AGENT); }
__device__ __forceinline__ unsigned xb_xcc_id() { return (unsigned)__builtin_amdgcn_s_getreg((3 << 11) | 20) & 0xFu; }
#define XB_SPIN(cond, bar) do { unsigned _sp = 0; while (cond) { __builtin_amdgcn_s_sleep(1); \
    if ((++_sp & 255u) == 0u) { if (xb_ld(&(bar)[XB_TMO])) break; if (_sp > XB_SPIN_CAP) { atomicAdd(&(bar)[XB_TMO], 1u); break; } } } } while (0)
struct XcdBarrier { unsigned* bar; unsigned x; volatile LAS unsigned* st; };
__device__ __forceinline__ XcdBarrier xcd_barrier_post(unsigned* bar, volatile LAS unsigned* st) {
    XcdBarrier b; b.bar = bar; b.x = xb_xcc_id(); b.st = st;
    if (threadIdx.x == 0) (void)xb_add(&bar[XB_XCNT(b.x)], 1u);
    return b;
}
__device__ __forceinline__ void xcd_barrier_complete(unsigned* bar, unsigned x, unsigned& nloc, unsigned& nx) {
    const unsigned G = gridDim.x * gridDim.y * gridDim.z;
    unsigned sum, cnt, mine, sp = 0u;
    for (;;) {
        sum = 0u; cnt = 0u; mine = 0u;
#pragma unroll
        for (unsigned j = 0; j < 16; ++j) { const unsigned c = xb_ld(&bar[XB_XCNT(j)]); sum += c; cnt += (c > 0u) ? 1u : 0u; mine = (j == x) ? c : mine; }
        if (sum == G) break;
        __builtin_amdgcn_s_sleep(1);
        if ((++sp & 255u) == 0u) { if (xb_ld(&bar[XB_TMO])) break; if (sp > XB_SPIN_CAP) { atomicAdd(&bar[XB_TMO], 1u); break; } }
    }
    nloc = mine > 0u ? mine : 1u; nx = cnt > 0u ? cnt : 1u;
}
__device__ __forceinline__ void xcd_barrier(const XcdBarrier& b) {
    asm volatile("s_waitcnt vmcnt(0)" ::: "memory");
    __syncthreads();
    if (threadIdx.x == 0) {
        unsigned* bar = b.bar;
        __builtin_amdgcn_s_waitcnt(0);
        unsigned nloc = b.st[0], nx = b.st[1];
        if (nloc == 0u) { xcd_barrier_complete(bar, b.x, nloc, nx); b.st[0] = nloc; b.st[1] = nx; }
        const unsigned old = xb_add(&bar[XB_XSUB(b.x)], 1u);
        const unsigned gen = old / nloc;
        if (old + 1u == (gen + 1u) * nloc) {
            __builtin_amdgcn_fence(__ATOMIC_RELEASE, "agent");
            asm volatile("s_waitcnt vmcnt(0)" ::: "memory");
            const unsigned og = xb_add(&bar[XB_TOP], 1u);
            const unsigned tg = og / nx;
            if (og + 1u == (tg + 1u) * nx) xb_add(&bar[XB_TOPGEN], 1u);
            else XB_SPIN(xb_ld(&bar[XB_TOPGEN]) == tg, bar);
            __builtin_amdgcn_fence(__ATOMIC_ACQUIRE, "agent");
            xb_add(&bar[XB_XGEN(b.x)], 1u);
            asm volatile("s_waitcnt vmcnt(0)" ::: "memory");
        } else {
            XB_SPIN(xb_ld(&bar[XB_XGEN(b.x)]) == gen, bar);
            __builtin_amdgcn_fence(__ATOMIC_ACQUIRE, "agent");
            asm volatile("s_waitcnt vmcnt(0)" ::: "memory");
        }
    }
    __syncthreads();
}

struct Args { const float* in[17]; float* out; unsigned char* ws; };

__device__ __forceinline__ void p0_transpose_item(const float* W, int K, int N, bf16_t* WT, int k0, int n0, int drow0, const float* kscale, LAS float* scr, int lane) {
    float wv[32];
#pragma unroll
    for (int i = 0; i < 32; ++i) wv[i] = W[(size_t)(k0 + 2 * i + (lane >> 5)) * N + n0 + (lane & 31)];
    if (kscale) {
#pragma unroll
        for (int i = 0; i < 32; ++i) wv[i] *= kscale[k0 + 2 * i + (lane >> 5)];
    }
#pragma unroll
    for (int i = 0; i < 32; ++i) scr[(2 * i + (lane >> 5)) * 33 + (lane & 31)] = wv[i];
    asm volatile("s_waitcnt lgkmcnt(0)" ::: "memory");
    const int c = lane & 7;
#pragma unroll
    for (int j = 0; j < 4; ++j) { const int n = (lane >> 3) + 8 * j; const LAS float* s = scr + (8 * c) * 33 + n;
        u32x4 o; o.x = pk2(s[0 * 33], s[1 * 33]); o.y = pk2(s[2 * 33], s[3 * 33]); o.z = pk2(s[4 * 33], s[5 * 33]); o.w = pk2(s[6 * 33], s[7 * 33]);
        *(u32x4*)(WT + (size_t)(drow0 + n) * K + k0 + 8 * c) = o; }
    asm volatile("s_waitcnt lgkmcnt(0)" ::: "memory");
}

__device__ __forceinline__ float lgam(int h) { return __logf(1.f - ex2(-5.f - (float)h)) * LOG2E; }

__device__ __forceinline__ void ret_local_item(ldsp lds, const bf16_t* proj, float* U, int item, int tid) {
    const int lane = tid & 63, wave = tid >> 6, fr = lane & 15, g = lane >> 4;
    const int bh = item >> 5, c = item & 31, b = bh >> 3, h = bh & 7;
    const float l2g = lgam(h);
    constexpr int RS = 144;
    ldsp KT = lds, VT = lds + 128 * RS;
    const size_t tok0 = (size_t)b * SEQ + c * 128;
    __syncthreads();
#pragma unroll
    for (int u = 0; u < 2; ++u) {
        const int idx = u * 512 + tid, j = idx >> 3, ch = idx & 7;
        const bf16_t* src = proj + (tok0 + j) * DIN + h * 64 + ch * 8;
        const u32x4 kv = *(const u32x4*)(src + C_RK), vv = *(const u32x4*)(src + C_RV);
        const float dec = 0.125f * ex2(l2g * (float)(127 - j));
        u32x4 kd;
#pragma unroll
        for (int e = 0; e < 4; ++e) { const unsigned kw = kv[e]; kd[e] = pk2(__uint_as_float(kw << 16) * dec, __uint_as_float(kw & 0xffff0000u) * dec); }
        *(LAS u32x4*)(KT + j * RS + ch * 16) = kd; *(LAS u32x4*)(VT + j * RS + ch * 16) = vv;
    }
    __syncthreads();
    float* Uo = U + (size_t)item * 4096;
#pragma unroll
    for (int t = 0; t < 2; ++t) {
        const int tile = wave * 2 + t, ti = tile >> 2, tj = tile & 3;
        f32x4 acc = {0.f, 0.f, 0.f, 0.f};
#pragma unroll
        for (int ks = 0; ks < 4; ++ks) {
            const bf16x8 a = tr_frag(KT, RS, ks * 32 + g * 8, ks * 32 + g * 8 + 4, ti * 16, fr);
            const bf16x8 bb = tr_frag(VT, RS, ks * 32 + g * 8, ks * 32 + g * 8 + 4, tj * 16, fr);
            acc = MFMA16(a, bb, acc);
        }
#pragma unroll
        for (int jj = 0; jj < 4; ++jj) Uo[(ti * 16 + 4 * g + jj) * 64 + tj * 16 + fr] = acc[jj];
    }
}

struct AttnRegs { u32x4 qv[2], kv[4], vv[4]; };
struct AttnItem { int b, h, br, d, r, i0; };
__device__ __forceinline__ AttnItem attn_decode(int item) {
    AttnItem t; const int bh = item / 96, rem = item - bh * 96, ci = rem & 31; t.br = rem >> 5; t.b = bh >> 3; t.h = bh & 7;
    const int dsh = 2 * t.br, cps = 32 >> dsh; t.d = 1 << dsh; t.r = ci / cps; t.i0 = (ci - t.r * cps) * 128; return t;
}
__device__ __forceinline__ void attn_load(AttnRegs& R, const bf16_t* proj, int item, int tid, bool need_lower) {
    const AttnItem t = attn_decode(item);
    const size_t tb = (size_t)t.b * SEQ + t.r; const int d = t.d, i0 = t.i0, h = t.h;
#pragma unroll
    for (int u = 0; u < 2; ++u) { const int idx = u * 512 + tid, row = idx >> 3, ch = idx & 7;
        R.qv[u] = *(const u32x4*)(proj + (tb + (size_t)(i0 + row) * d) * DIN + C_AQ + h * 64 + ch * 8); }
#pragma unroll
    for (int u = 0; u < 2; ++u) { const int idx = u * 512 + tid, row = idx >> 3, ch = idx & 7;
        const bf16_t* src = proj + (tb + (size_t)(i0 + row) * d) * DIN + h * 64 + ch * 8;
        R.kv[u] = *(const u32x4*)(src + C_AK); R.vv[u] = *(const u32x4*)(src + C_AV); }
    if (need_lower) {
#pragma unroll
        for (int u = 0; u < 2; ++u) { const int idx = u * 512 + tid, row = idx >> 3, ch = idx & 7;
            const bf16_t* src = proj + (tb + (size_t)(i0 - 128 + row) * d) * DIN + h * 64 + ch * 8;
            R.kv[2 + u] = *(const u32x4*)(src + C_AK); R.vv[2 + u] = *(const u32x4*)(src + C_AV); }
    }
}
constexpr int AT_QS = 144, AT_VS = 528;
__device__ __forceinline__ void attn_store(ldsp lds, const AttnRegs& R, int tid, int parity, bool need_lower) {
    ldsp Qs = lds, Ks = lds + 128 * AT_QS, VT = Ks + 256 * AT_QS;
    const int up = parity * 128, lo = (1 - parity) * 128;
#pragma unroll
    for (int u = 0; u < 2; ++u) { const int idx = u * 512 + tid, row = idx >> 3, ch = idx & 7;
        *(LAS u32x4*)(Qs + row * AT_QS + ch * 16) = R.qv[u];
        *(LAS u32x4*)(Ks + (up + row) * AT_QS + ch * 16) = R.kv[u]; *(LAS u32x4*)(VT + (up + row) * AT_QS + ch * 16) = R.vv[u]; }
    if (need_lower) {
#pragma unroll
        for (int u = 0; u < 2; ++u) { const int idx = u * 512 + tid, row = idx >> 3, ch = idx & 7;
            *(LAS u32x4*)(Ks + (lo + row) * AT_QS + ch * 16) = R.kv[2 + u]; *(LAS u32x4*)(VT + (lo + row) * AT_QS + ch * 16) = R.vv[2 + u]; }
    }
}
__device__ __forceinline__ void attn_compute(ldsp lds, bf16_t* atto, float* attml, int item, int tid, int parity) {
    constexpr int QS = AT_QS, VS = AT_VS;
    const int lane = tid & 63, wave = __builtin_amdgcn_readfirstlane(tid >> 6), fr = lane & 15, g = lane >> 4;
    const AttnItem t = attn_decode(item);
    const int d = t.d, i0 = t.i0, h = t.h, br = t.br;
    const size_t tb = (size_t)t.b * SEQ + t.r;
    const bool first = (i0 == 0);
    ldsp Qs = lds, Ks = lds + 128 * QS, VT = Ks + 256 * QS;
    const int qi0 = wave * 16, qi = qi0 + fr;
    const bf16x8 bq0 = *(const LAS bf16x8*)(Qs + qi * QS + g * 16), bq1 = *(const LAS bf16x8*)(Qs + qi * QS + 64 + g * 16);
    const float slope = ex2(-(float)(h + 1));
    const float sc = 0.125f * LOG2E, sl = slope * (float)d * LOG2E;
    float mrun = -1e30f, lsum = 0.f;
    f32x4 ot[4];
#pragma unroll
    for (int et = 0; et < 4; ++et) ot[et] = (f32x4){0.f, 0.f, 0.f, 0.f};
    int kt_lo = qi0 >> 5; if (first && kt_lo < 4) kt_lo = 4;
    const int kt_hi = (qi0 + 15 + 128) >> 5;
#define AT_KB(kt) (((((kt) >> 2) ^ parity ^ 1) & 1) << 7 | (((kt) & 3) << 5))
    bf16x8 kf[2][2][2];
    {
        const int k1 = (kt_lo + 1 <= kt_hi) ? kt_lo + 1 : kt_lo; const int kb0 = AT_KB(kt_lo), kb1 = AT_KB(k1);
#pragma unroll
        for (int hf = 0; hf < 2; ++hf) {
            ldsp kp0 = Ks + (kb0 + hf * 16 + fr) * QS + g * 16; ldsp kp1 = Ks + (kb1 + hf * 16 + fr) * QS + g * 16;
            kf[0][hf][0] = *(const LAS bf16x8*)kp0; kf[0][hf][1] = *(const LAS bf16x8*)(kp0 + 64);
            kf[1][hf][0] = *(const LAS bf16x8*)kp1; kf[1][hf][1] = *(const LAS bf16x8*)(kp1 + 64);
        }
    }
    for (int kt0 = kt_lo; kt0 <= kt_hi; kt0 += 2) {
        const bool two = (kt0 + 1 <= kt_hi);
        const int ktv[2] = {kt0, two ? kt0 + 1 : kt0};
        int kbv[2];
#pragma unroll
        for (int tt = 0; tt < 2; ++tt) kbv[tt] = AT_KB(ktv[tt]);
        f32x4 st[4];
#pragma unroll
        for (int tt = 0; tt < 2; ++tt)
#pragma unroll
            for (int hf = 0; hf < 2; ++hf) {
                st[tt * 2 + hf] = MFMA16(kf[tt][hf][0], bq0, ((f32x4){0.f, 0.f, 0.f, 0.f}));
                st[tt * 2 + hf] = MFMA16(kf[tt][hf][1], bq1, st[tt * 2 + hf]);
            }
        bf16x8 vf[2][4];
#pragma unroll
        for (int tt = 0; tt < 2; ++tt)
#pragma unroll
            for (int et = 0; et < 4; ++et) vf[tt][et] = tr_frag(VT, QS, kbv[tt] + 4 * g, kbv[tt] + 16 + 4 * g, et * 16, fr);
        {
            const int n0 = (kt0 + 2 <= kt_hi) ? kt0 + 2 : kt_hi, n1 = (kt0 + 3 <= kt_hi) ? kt0 + 3 : kt_hi; const int kb0 = AT_KB(n0), kb1 = AT_KB(n1);
#pragma unroll
            for (int hf = 0; hf < 2; ++hf) {
                ldsp kp0 = Ks + (kb0 + hf * 16 + fr) * QS + g * 16; ldsp kp1 = Ks + (kb1 + hf * 16 + fr) * QS + g * 16;
                kf[0][hf][0] = *(const LAS bf16x8*)kp0; kf[0][hf][1] = *(const LAS bf16x8*)(kp0 + 64);
                kf[1][hf][0] = *(const LAS bf16x8*)kp1; kf[1][hf][1] = *(const LAS bf16x8*)(kp1 + 64);
            }
        }
        float s[16]; float tmax = -INFINITY;
#pragma unroll
        for (int tt = 0; tt < 2; ++tt)
#pragma unroll
            for (int hf = 0; hf < 2; ++hf)
#pragma unroll
                for (int jj = 0; jj < 4; ++jj) {
                    const int kj = ktv[tt] * 32 + hf * 16 + 4 * g + jj, dist = qi + 128 - kj;
                    const bool ok = ((unsigned)dist <= 128u) && (tt == 0 || two);
                    const float v = ok ? st[tt * 2 + hf][jj] * sc - sl * (float)dist : -INFINITY;
                    s[tt * 8 + hf * 4 + jj] = v; tmax = fmaxf(tmax, v);
                }
        tmax = fmaxf(tmax, __shfl_xor(tmax, 16)); tmax = fmaxf(tmax, __shfl_xor(tmax, 32));
        const float mnew = fmaxf(mrun, tmax), alpha = ex2(mrun - mnew); mrun = mnew;
        float ps = 0.f;
#pragma unroll
        for (int e = 0; e < 16; ++e) { s[e] = ex2(s[e] - mnew); ps += s[e]; }
        lsum = lsum * alpha + ps;
#pragma unroll
        for (int et = 0; et < 4; ++et) ot[et] = ot[et] * alpha;
#pragma unroll
        for (int tt = 0; tt < 2; ++tt) {
            u32x4 pw; pw.x = pk2(s[tt * 8 + 0], s[tt * 8 + 1]); pw.y = pk2(s[tt * 8 + 2], s[tt * 8 + 3]); pw.z = pk2(s[tt * 8 + 4], s[tt * 8 + 5]); pw.w = pk2(s[tt * 8 + 6], s[tt * 8 + 7]);
            const bf16x8 pf = __builtin_bit_cast(bf16x8, pw);
#pragma unroll
            for (int et = 0; et < 4; ++et) ot[et] = MFMA16(vf[tt][et], pf, ot[et]);
        }
    }
#undef AT_KB
    lsum += __shfl_xor(lsum, 16); lsum += __shfl_xor(lsum, 32);
    const float inv = __builtin_amdgcn_rcpf(lsum);
    const size_t tok = tb + (size_t)(i0 + qi) * d;
    bf16_t* od = atto + ((size_t)br * MP + tok) * 512 + h * 64;
#pragma unroll
    for (int et = 0; et < 4; ++et) { u32x2 w; w.x = pk2(ot[et][0] * inv, ot[et][1] * inv); w.y = pk2(ot[et][2] * inv, ot[et][3] * inv);
        *(u32x2*)(od + et * 16 + 4 * g) = w; }
    if (g == 0) { f32x2 ml = {mrun, lsum}; *(f32x2*)(attml + (((size_t)br * MP + tok) * 8 + h) * 2) = ml; }
}

__device__ __forceinline__ void sample_item(ldsp lds, const Args& a, const bf16_t* proj, bf16_t* mix, int item, int tid) {
    const int lane = tid & 63, wave = tid >> 6, b = item >> 3, h = item & 7;
    LAS float* qs = (LAS float*)lds;
    LAS float* ks = qs + 512;
    LAS float* vs = ks + 512;
    LAS float* aq = vs + 512;
    LAS float* sc = aq + 512;
    LAS float* part = sc + 64;
    LAS float* pbuf = part + 4096;
    const float l2g = lgam(h);
    __syncthreads();
    {
        const int i = tid >> 6, e = tid & 63;
        const bf16_t* src = proj + (size_t)(MP + b * 8 + i) * DIN + h * 64 + e;
        qs[tid] = bf2f(src[C_RQ]); ks[tid] = bf2f(src[C_RK]) * 0.125f; vs[tid] = bf2f(src[C_RV]); aq[tid] = bf2f(src[C_AQ]) * 0.125f;
    }
    __syncthreads();
    if (tid < 64) { const int i = tid >> 3, j = tid & 7; float s = 0.f;
        if (j <= i) {
#pragma unroll 4
            for (int dd = 0; dd < 64; ++dd) s += qs[i * 64 + dd] * ks[j * 64 + dd];
            s *= ex2(l2g * (float)(i - j)); }
        sc[tid] = s; }
    {
        const int e = tid & 63, dkg = tid >> 6;
        const float* S0 = a.in[2] + ((size_t)(b * 8 + h) * 64 + dkg * 8) * 64 + e;
        float* So = a.out + O_RETS + ((size_t)(b * 8 + h) * 64 + dkg * 8) * 64 + e;
        float cr[8];
#pragma unroll
        for (int i = 0; i < 8; ++i) cr[i] = 0.f;
        const float g8 = ex2(l2g * 8.f);
        float vd[8];
#pragma unroll
        for (int i = 0; i < 8; ++i) vd[i] = ex2(l2g * (float)(7 - i)) * vs[i * 64 + e];
        float s0v[8];
#pragma unroll
        for (int k = 0; k < 8; ++k) s0v[k] = S0[k * 64];
#pragma unroll
        for (int k = 0; k < 8; ++k) {
            const int dk = dkg * 8 + k; const float s0 = s0v[k];
            float sn = s0 * g8;
#pragma unroll
            for (int i = 0; i < 8; ++i) { cr[i] += qs[i * 64 + dk] * s0; sn += ks[i * 64 + dk] * vd[i]; }
            So[k * 64] = sn;
        }
#pragma unroll
        for (int i = 0; i < 8; ++i) part[(dkg * 8 + i) * 64 + e] = cr[i];
    }
    __syncthreads();
    {
        const int i = wave, e = lane; float o = 0.f;
#pragma unroll
        for (int dkg = 0; dkg < 8; ++dkg) o += part[(dkg * 8 + i) * 64 + e];
        o *= ex2(l2g * (float)(i + 1));
        for (int j = 0; j <= i; ++j) o += sc[i * 8 + j] * vs[j * 64 + e];
        const float mu = wave_sum(o) * (1.f / 64.f), dv = o - mu, var = wave_sum(dv * dv) * (1.f / 64.f);
        const float nrm = dv * __builtin_amdgcn_rsqf(var + EPS) * a.in[8][h * 64 + e] + a.in[9][h * 64 + e];
        const size_t tok = (size_t)MP + b * 8 + i;
        const float gate = bf2f(proj[tok * DIN + C_RG + h * 64 + e]);
        mix[tok * DM + h * 64 + e] = f2bf(silu(gate) * nrm);
    }
    {
        const int i = wave, kg = lane >> 4, dc = lane & 15;
        const float* ck = a.in[3] + (size_t)b * WINR * 512 + h * 64 + 4 * dc; const float* cvp = a.in[4] + (size_t)b * WINR * 512 + h * 64 + 4 * dc;
        const float* nk = a.out + O_WKS + ((size_t)b * WINR + (WINR - STOK)) * 512 + h * 64 + 4 * dc; const float* nv = a.out + O_WVS + ((size_t)b * WINR + (WINR - STOK)) * 512 + h * 64 + 4 * dc;
        const float slope = ex2(-(float)(h + 1));
        LAS float* pw = pbuf + wave * 448;
        const f32x4 q4 = *(const LAS f32x4*)(aq + i * 64 + 4 * dc);
#pragma unroll 1
        for (int it0 = 0; it0 < 99; it0 += 33)
#pragma unroll
        for (int iu = 0; iu < 33; ++iu) {
            const int idx = (it0 + iu) * 4 + kg, idc = idx < 387 ? idx : 386;
            const int br = idc >= 258 ? 2 : (idc >= 129 ? 1 : 0), n = idc - br * 129, dist = n << (2 * br), loc = WINR + i - dist;
            const float* kr = loc < WINR ? ck + (size_t)loc * 512 : nk + (size_t)(loc - WINR) * 512;
            const f32x4 kk = *(const f32x4*)kr;
            float dot = (kk[0] * q4[0] + kk[1] * q4[1]) + (kk[2] * q4[2] + kk[3] * q4[3]);
            dot += __int_as_float(__builtin_amdgcn_update_dpp(0, __float_as_int(dot), 0x128, 0xf, 0xf, false));
            dot += __int_as_float(__builtin_amdgcn_update_dpp(0, __float_as_int(dot), 0x124, 0xf, 0xf, false));
            dot += __int_as_float(__builtin_amdgcn_update_dpp(0, __float_as_int(dot), 0x122, 0xf, 0xf, false));
            dot += __int_as_float(__builtin_amdgcn_update_dpp(0, __float_as_int(dot), 0x121, 0xf, 0xf, false));
            if (dc == 0 && idx < 387) pw[idx] = (dot - slope * (float)dist) * LOG2E;
        }
        asm volatile("s_waitcnt lgkmcnt(0)" ::: "memory");
        float mx = -INFINITY;
        for (int u = 0; u < 7; ++u) { const int idx = u * 64 + lane; if (idx < 387) mx = fmaxf(mx, pw[idx]); }
        mx = wave_max(mx);
        float ssum = 0.f;
        for (int u = 0; u < 7; ++u) { const int idx = u * 64 + lane; if (idx < 387) { const float p = ex2(pw[idx] - mx); pw[idx] = p; ssum += p; } }
        ssum = wave_sum(ssum);
        asm volatile("s_waitcnt lgkmcnt(0)" ::: "memory");
        f32x4 o = {0.f, 0.f, 0.f, 0.f};
#pragma unroll 1
        for (int it0 = 0; it0 < 99; it0 += 33)
#pragma unroll
        for (int iu = 0; iu < 33; ++iu) {
            const int idx = (it0 + iu) * 4 + kg, idc = idx < 387 ? idx : 386;
            const int br = idc >= 258 ? 2 : (idc >= 129 ? 1 : 0), n = idc - br * 129, loc = WINR + i - (n << (2 * br));
            const float* vr = loc < WINR ? cvp + (size_t)loc * 512 : nv + (size_t)(loc - WINR) * 512;
            const float p = idx < 387 ? pw[idc] : 0.f;
            o = o + *(const f32x4*)vr * p;
        }
#pragma unroll
        for (int e = 0; e < 4; ++e) { o[e] += __shfl_xor(o[e], 16); o[e] += __shfl_xor(o[e], 32); }
        if (kg == 0) {
            const float inv = 1.f / ssum; const size_t tok = (size_t)MP + b * 8 + i;
            u32x2 w; w.x = pk2(o[0] * inv, o[1] * inv); w.y = pk2(o[2] * inv, o[3] * inv);
            *(u32x2*)(mix + tok * DM + 512 + h * 64 + 4 * dc) = w;
        }
    }
}

struct RetRegs { u32x4 q[2], k[2], v[2], s; };
__device__ __forceinline__ void ret_load(RetRegs& R, const bf16_t* proj, const bf16_t* sin, int item, int tid) {
    const int bh = item >> 5, c = item & 31, b = bh >> 3, h = bh & 7;
    const size_t tok0 = (size_t)b * SEQ + c * 128;
#pragma unroll
    for (int u = 0; u < 2; ++u) {
        const int idx = u * 512 + tid, row = idx >> 3, ch = idx & 7; const bf16_t* src = proj + (tok0 + row) * DIN + h * 64 + ch * 8;
        R.q[u] = *(const u32x4*)(src + C_RQ); R.k[u] = *(const u32x4*)(src + C_RK); R.v[u] = *(const u32x4*)(src + C_RV);
    }
    { const int dk = tid >> 3, ch = tid & 7; R.s = *(const u32x4*)(sin + (size_t)item * 4096 + dk * 64 + ch * 8); }
}
__device__ __forceinline__ void ret_store(ldsp lds, const RetRegs& R, int tid) {
    constexpr int QS = 144;
    ldsp Qs = lds, Ks = lds + 128 * QS, VT = Ks + 128 * QS, STt = VT + 128 * QS;
#pragma unroll
    for (int u = 0; u < 2; ++u) {
        const int idx = u * 512 + tid, row = idx >> 3, ch = idx & 7;
        *(LAS u32x4*)(Qs + row * QS + ch * 16) = R.q[u]; *(LAS u32x4*)(Ks + row * QS + ch * 16) = R.k[u]; *(LAS u32x4*)(VT + row * QS + ch * 16) = R.v[u];
    }
    { const int dk = tid >> 3, ch = tid & 7; *(LAS u32x4*)(STt + dk * QS + ch * 16) = R.s; }
}
__device__ __forceinline__ void ret_compute(ldsp lds, const Args& a, const bf16_t* proj, const bf16_t* atto, const float* attml, bf16_t* mix, int item, int tid) {
    const int lane = tid & 63, wave = __builtin_amdgcn_readfirstlane(tid >> 6), fr = lane & 15, g = lane >> 4;
    const int bh = item >> 5, c = item & 31, b = bh >> 3, h = bh & 7;
    const float l2g = lgam(h);
    constexpr int QS = 144;
    ldsp Qs = lds, Ks = lds + 128 * QS, VT = Ks + 128 * QS, STt = VT + 128 * QS;
    const size_t tok0 = (size_t)b * SEQ + c * 128;
    const int mt = tid >> 2, meg = (tid & 3) * 16; const size_t mtk = tok0 + mt;
    f32x2 mml[3]; u32x4 mv0[3], mv1[3];
#pragma unroll
    for (int br = 0; br < 3; ++br) { mml[br] = *(const f32x2*)(attml + (((size_t)br * MP + mtk) * 8 + h) * 2);
        const bf16_t* src = atto + ((size_t)br * MP + mtk) * 512 + h * 64 + meg; mv0[br] = *(const u32x4*)src; mv1[br] = *(const u32x4*)(src + 8); }
    const int qi0 = wave * 16, qi = qi0 + fr;
    const bf16x8 bq0 = *(const LAS bf16x8*)(Qs + qi * QS + g * 16), bq1 = *(const LAS bf16x8*)(Qs + qi * QS + 64 + g * 16);
    f32x4 ot[4], xs[4];
#pragma unroll
    for (int et = 0; et < 4; ++et) {
        ot[et] = (f32x4){0.f, 0.f, 0.f, 0.f};
        xs[et] = MFMA16(tr_frag(STt, QS, g * 8, g * 8 + 4, et * 16, fr), bq0, ((f32x4){0.f, 0.f, 0.f, 0.f}));
        xs[et] = MFMA16(tr_frag(STt, QS, 32 + g * 8, 32 + g * 8 + 4, et * 16, fr), bq1, xs[et]);
    }
    const int kt_hi = (qi0 + 15) >> 5;
    for (int kt = 0; kt <= kt_hi; ++kt) {
        f32x4 st[2];
#pragma unroll
        for (int hf = 0; hf < 2; ++hf) {
            ldsp kp = Ks + (kt * 32 + hf * 16 + fr) * QS + g * 16;
            st[hf] = MFMA16(*(const LAS bf16x8*)kp, bq0, ((f32x4){0.f, 0.f, 0.f, 0.f}));
            st[hf] = MFMA16(*(const LAS bf16x8*)(kp + 64), bq1, st[hf]);
        }
        float s[8];
#pragma unroll
        for (int hf = 0; hf < 2; ++hf)
#pragma unroll
            for (int jj = 0; jj < 4; ++jj) { const int dj = qi - (kt * 32 + hf * 16 + 4 * g + jj);
                s[hf * 4 + jj] = dj >= 0 ? st[hf][jj] * 0.125f * ex2(l2g * (float)dj) : 0.f; }
        u32x4 pw; pw.x = pk2(s[0], s[1]); pw.y = pk2(s[2], s[3]); pw.z = pk2(s[4], s[5]); pw.w = pk2(s[6], s[7]);
        const bf16x8 pf = __builtin_bit_cast(bf16x8, pw);
#pragma unroll
        for (int et = 0; et < 4; ++et) {
            ot[et] = MFMA16(tr_frag(VT, QS, kt * 32 + 4 * g, kt * 32 + 16 + 4 * g, et * 16, fr), pf, ot[et]);
        }
    }
    const float qdec = ex2(l2g * (float)(qi + 1));
    float sum = 0.f;
#pragma unroll
    for (int et = 0; et < 4; ++et) { ot[et] = ot[et] + xs[et] * qdec; sum += (ot[et][0] + ot[et][1]) + (ot[et][2] + ot[et][3]); }
    sum += __shfl_xor(sum, 16); sum += __shfl_xor(sum, 32);
    const float mu = sum * (1.f / 64.f); float vsum = 0.f;
#pragma unroll
    for (int et = 0; et < 4; ++et) { ot[et] = ot[et] - mu; vsum += (ot[et][0] * ot[et][0] + ot[et][1] * ot[et][1]) + (ot[et][2] * ot[et][2] + ot[et][3] * ot[et][3]); }
    vsum += __shfl_xor(vsum, 16); vsum += __shfl_xor(vsum, 32);
    const float rstd = __builtin_amdgcn_rsqf(vsum * (1.f / 64.f) + EPS);
    const size_t tok = tok0 + qi;
#pragma unroll
    for (int et = 0; et < 4; ++et) {
        const int ch = h * 64 + et * 16 + 4 * g;
        const f32x4 gw = *(const f32x4*)(a.in[8] + ch), gb = *(const f32x4*)(a.in[9] + ch);
        const u32x2 rgw = *(const u32x2*)(proj + tok * DIN + C_RG + ch);
        const float g0 = __uint_as_float(rgw.x << 16), g1 = __uint_as_float(rgw.x & 0xffff0000u), g2 = __uint_as_float(rgw.y << 16), g3 = __uint_as_float(rgw.y & 0xffff0000u);
        u32x2 w;
        w.x = pk2(silu(g0) * (ot[et][0] * rstd * gw[0] + gb[0]), silu(g1) * (ot[et][1] * rstd * gw[1] + gb[1]));
        w.y = pk2(silu(g2) * (ot[et][2] * rstd * gw[2] + gb[2]), silu(g3) * (ot[et][3] * rstd * gw[3] + gb[3]));
        *(u32x2*)(mix + tok * DM + ch) = w;
    }
    {
        const int eg = meg; const size_t tk = mtk;
        float mm[3], ll[3], M = -INFINITY;
#pragma unroll
        for (int br = 0; br < 3; ++br) { mm[br] = mml[br].x; ll[br] = mml[br].y; M = fmaxf(M, mml[br].x); }
        float wsum = 0.f, wt[3];
#pragma unroll
        for (int br = 0; br < 3; ++br) { wt[br] = ll[br] * ex2(mm[br] - M); wsum += wt[br]; }
        const float winv = __builtin_amdgcn_rcpf(wsum);
        float o[16];
#pragma unroll
        for (int e = 0; e < 16; ++e) o[e] = 0.f;
#pragma unroll
        for (int br = 0; br < 3; ++br) {
            const float w = wt[br] * winv;
            const u32x4 v0 = mv0[br], v1 = mv1[br];
#pragma unroll
            for (int e = 0; e < 4; ++e) { o[2 * e] += w * __uint_as_float(v0[e] << 16); o[2 * e + 1] += w * __uint_as_float(v0[e] & 0xffff0000u);
                                          o[8 + 2 * e] += w * __uint_as_float(v1[e] << 16); o[8 + 2 * e + 1] += w * __uint_as_float(v1[e] & 0xffff0000u); }
        }
        u32x4 w0, w1; w0.x = pk2(o[0], o[1]); w0.y = pk2(o[2], o[3]); w0.z = pk2(o[4], o[5]); w0.w = pk2(o[6], o[7]);
        w1.x = pk2(o[8], o[9]); w1.y = pk2(o[10], o[11]); w1.z = pk2(o[12], o[13]); w1.w = pk2(o[14], o[15]);
        bf16_t* dst = mix + tk * DM + 512 + h * 64 + eg; *(u32x4*)dst = w0; *(u32x4*)(dst + 8) = w1;
    }
}

__device__ __forceinline__ void cache_copy(const Args& a, int lo, int hi, int worker, int nw, int tid) {
    constexpr int PB4 = (WINR - STOK) * 512 / 4;
    const f32x4* ck = (const f32x4*)a.in[3]; const f32x4* cv = (const f32x4*)a.in[4];
    f32x4* ok = (f32x4*)(a.out + O_WKS); f32x4* ov = (f32x4*)(a.out + O_WVS);
    for (int i0 = lo + worker * 2048 + tid; i0 < hi; i0 += nw * 2048) {
        f32x4 kk[4], vv[4]; size_t dd[4];
#pragma unroll
        for (int u = 0; u < 4; ++u) { int i = i0 + u * 512; if (i >= hi) i = hi - 1; const int b = i / PB4, j = i - b * PB4; dd[u] = (size_t)b * (WINR * 128) + j;
            kk[u] = __builtin_nontemporal_load(ck + dd[u] + STOK * 128); vv[u] = __builtin_nontemporal_load(cv + dd[u] + STOK * 128); }
#pragma unroll
        for (int u = 0; u < 4; ++u) { __builtin_nontemporal_store(kk[u], ok + dd[u]); __builtin_nontemporal_store(vv[u], ov + dd[u]); }
    }
}
constexpr int CC_TOT = SBAT * ((WINR - STOK) * 512 / 4), CC_1 = (22 * (CC_TOT / 100)) & ~2047, CC_2 = (40 * (CC_TOT / 100)) & ~2047;
constexpr int P1_COPY_BLOCKS = 28;

__global__ void __launch_bounds__(512, 2) fwd(Args a) {
    extern __shared__ __attribute__((aligned(16))) unsigned char lds_raw[];
    cg::grid_group grid = cg::this_grid();
    ldsp lds = (ldsp)lds_raw;
    const int G = gridDim.x, bx = blockIdx.x;
    volatile LAS unsigned* xbst = (volatile LAS unsigned*)(lds + LDS_BYTES - 16);
    if (threadIdx.x < 4) xbst[threadIdx.x] = 0u;
    __syncthreads();
    const XcdBarrier xbar = xcd_barrier_post((unsigned*)(a.ws + WS_BAR), xbst);
#define PHASE_IDS int tid = threadIdx.x; asm volatile("" : "+v"(tid)); const int lane = tid & 63, wave = __builtin_amdgcn_readfirstlane(tid >> 6); (void)lane; (void)wave;
    unsigned char* ws = a.ws;
    bf16_t* WinT = (bf16_t*)(ws + WS_WIN); bf16_t* WoutT = (bf16_t*)(ws + WS_WOUT); bf16_t* WupT = (bf16_t*)(ws + WS_WUP); bf16_t* WdnT = (bf16_t*)(ws + WS_WDN);
    float* RSQ = (float*)(ws + WS_RSQ); float* RSQ2 = (float*)(ws + WS_RSQ2); bf16_t* H1 = (bf16_t*)(ws + WS_H1); bf16_t* PROJ = (bf16_t*)(ws + WS_PROJ);
    float* U = (float*)(ws + WS_U); bf16_t* SIN = (bf16_t*)(ws + WS_SIN); bf16_t* ATTO = (bf16_t*)(ws + WS_ATTO); float* ATTML = (float*)(ws + WS_ATTML);
    bf16_t* MIX = (bf16_t*)(ws + WS_MIX); float* X1 = (float*)(ws + WS_X1); bf16_t* X1B = (bf16_t*)(ws + WS_X1B); bf16_t* GB = (bf16_t*)(ws + WS_G);

#if !defined(ONLY) || ONLY == 0
    REPS(0)
    {
        PHASE_IDS
        LAS float* scr = (LAS float*)(lds + wave * 16384);
        const int gw = bx * 8 + wave, NGW = G * 8;
        constexpr int I_IN = 16 * 112, I_OUT = 16 * 32, I_UP = 16 * 176, I_DN = 44 * 32, NIT = I_IN + I_OUT + I_UP + I_DN;
        for (int it = gw; it < NIT; it += NGW) {
            int r = it;
            if (r < I_IN) { const int kb = r / 112, nb = r - kb * 112; p0_transpose_item(a.in[7], DM, DIN, WinT, kb * 64, nb * 32, nb * 32, nullptr, scr, lane); continue; } r -= I_IN;
            if (r < I_OUT) { const int kb = r >> 5, nb = r & 31; p0_transpose_item(a.in[10], DM, DM, WoutT, kb * 64, nb * 32, nb * 32, nullptr, scr, lane); continue; } r -= I_OUT;
            if (r < I_UP) { const int kb = r / 176, nb = r - kb * 176; const int n0 = nb * 32; const int mm = n0 < DFF ? n0 : n0 - DFF;
                const int drow = 256 * (mm >> 7) + (mm & 127) + (n0 < DFF ? 0 : 128);
                p0_transpose_item(a.in[12], DM, NUP, WupT, kb * 64, n0, drow, a.in[11], scr, lane); continue; } r -= I_UP;
            { const int kb = r >> 5, nb = r & 31; p0_transpose_item(a.in[15], DFF, DM, WdnT, kb * 64, nb * 32, nb * 32, nullptr, scr, lane); }
        }
        for (int m0 = gw; m0 < MT; m0 += 2 * NGW) {
            const int m1 = m0 + NGW; const bool has1 = m1 < MT; const int m1c = has1 ? m1 : m0;
            const float* xr0 = m0 < MP ? a.in[0] + (size_t)m0 * DM : a.in[1] + (size_t)(m0 - MP) * DM;
            const float* xr1 = m1c < MP ? a.in[0] + (size_t)m1c * DM : a.in[1] + (size_t)(m1c - MP) * DM;
            f32x4 v0[4], v1[4]; float s0 = 0.f, s1 = 0.f;
#pragma unroll
            for (int j = 0; j < 4; ++j) { v0[j] = *(const f32x4*)(xr0 + 4 * lane + 256 * j); v1[j] = *(const f32x4*)(xr1 + 4 * lane + 256 * j); }
#pragma unroll
            for (int j = 0; j < 4; ++j) { s0 += (v0[j][0] * v0[j][0] + v0[j][1] * v0[j][1]) + (v0[j][2] * v0[j][2] + v0[j][3] * v0[j][3]);
                                          s1 += (v1[j][0] * v1[j][0] + v1[j][1] * v1[j][1]) + (v1[j][2] * v1[j][2] + v1[j][3] * v1[j][3]); }
            const float r0 = __builtin_amdgcn_rsqf(wave_sum(s0) * (1.f / DM) + EPS), r1 = __builtin_amdgcn_rsqf(wave_sum(s1) * (1.f / DM) + EPS);
#pragma unroll
            for (int j = 0; j < 4; ++j) { const f32x4 w = *(const f32x4*)(a.in[6] + 4 * lane + 256 * j);
                u32x2 o; o.x = pk2(v0[j][0] * r0 * w[0], v0[j][1] * r0 * w[1]); o.y = pk2(v0[j][2] * r0 * w[2], v0[j][3] * r0 * w[3]);
                *(u32x2*)(H1 + (size_t)m0 * DM + 4 * lane + 256 * j) = o;
                if (has1) { u32x2 p; p.x = pk2(v1[j][0] * r1 * w[0], v1[j][1] * r1 * w[1]); p.y = pk2(v1[j][2] * r1 * w[2], v1[j][3] * r1 * w[3]);
                    *(u32x2*)(H1 + (size_t)m1 * DM + 4 * lane + 256 * j) = p; } }
        }
        const int gt = bx * 512 + tid, NGT = G * 512;
        for (int i = gt; i < MT; i += NGT) { RSQ[i] = 0.f; RSQ2[i] = 0.f; }
        for (int i = gt; i < NB * 2 * DM / 2; i += NGT) { const int b = i / DM, c = i - b * DM; ((unsigned*)(X1B + (size_t)b * X1B_PB * DM))[c] = 0u; }
        if (G < 128) cache_copy(a, 0, CC_1, bx, G, tid);
    }
#endif
    if (a.ws == nullptr) grid.sync();
    xcd_barrier(xbar);
#if !defined(ONLY) || ONLY == 1
    REPS(1)
#if (DBL_MASK) & 512
    for (int r_ = 0; r_ < 8; ++r_) xcd_barrier(xbar);
#endif
    {
        const int Gg = G >= 128 ? G - P1_COPY_BLOCKS : G;
        if (bx < Gg) {
        pg8::StaticOrder S; S.init(MT / 256, DIN / 256, Gg, bx);
        AMapStd AM{(const char*)H1, (size_t)256 * DM * 2, (size_t)128 * DM * 2};
        Epi1 E{PROJ, a.out};
        pg8::gemm_phase(lds, WinT, DM, S, AM, E);
        } else cache_copy(a, 0, CC_1, bx - Gg, G - Gg, threadIdx.x);
    }
#endif
    xcd_barrier(xbar);
#if !defined(ONLY) || ONLY == 2
    REPS(2)
    {
        PHASE_IDS
        constexpr int N_S = SBAT * 8, N_A = 32 * 96, N_U = 1024;
        for (int it = bx; it < N_S; it += G) { sample_item(lds, a, PROJ, MIX, it, tid); if ((DBL_MASK) & 1024) sample_item(lds, a, PROJ, MIX, it, tid); }
        {
            const int vb = (G % 8 == 0) ? (bx % 8) * (G / 8) + bx / 8 : bx;
            AttnRegs R; const int it_lo = (int)((long)vb * N_A / G), it_hi = (int)((long)(vb + 1) * N_A / G);
            int it = it_lo;
            bool nl = (it < it_hi) && (attn_decode(it).i0 != 0);
            if (it < it_hi) attn_load(R, PROJ, it, tid, nl);
            while (it < it_hi) {
                const int parity = (it - it_lo) & 1;
                __syncthreads();
                attn_store(lds, R, tid, parity, nl);
                __syncthreads();
                const int nx = it + 1;
                nl = false;
                if (nx < it_hi) attn_load(R, PROJ, nx, tid, false);
                attn_compute(lds, ATTO, ATTML, it, tid, parity);
                it = nx;
            }
        }
        for (int it = bx; it < N_U; it += G) ret_local_item(lds, PROJ, U, it, tid);
    }
#endif
    xcd_barrier(xbar);
#if !defined(ONLY) || ONLY == 3
    REPS(3)
    {
        PHASE_IDS
        for (int idx = bx * 512 + tid; idx < NB * 8 * 4096; idx += G * 512) {
            const int bh = idx >> 12, el = idx & 4095, h = bh & 7;
            const float g128 = ex2(lgam(h) * 128.f);
            float s = 0.f, uv[32];
#pragma unroll
            for (int c = 0; c < 32; ++c) uv[c] = U[((size_t)bh * 32 + c) * 4096 + el];
#pragma unroll
            for (int c = 0; c < 32; ++c) { SIN[((size_t)bh * 32 + c) * 4096 + el] = f2bf(s); s = s * g128 + uv[c]; }
            a.out[O_RETP + idx] = s;
        }
    }
#endif
    xcd_barrier(xbar);
#if !defined(ONLY) || ONLY == 4
    REPS(4)
    { PHASE_IDS
    RetRegs R; int it = bx;
    if (it < 1024) ret_load(R, PROJ, SIN, it, tid);
    while (it < 1024) {
        __syncthreads();
        ret_store(lds, R, tid);
        __syncthreads();
        const int nx = it + G;
        if (nx < 1024) ret_load(R, PROJ, SIN, nx, tid);
        ret_compute(lds, a, PROJ, ATTO, ATTML, MIX, it, tid);
        it = nx;
    }
    __syncthreads(); }
#endif
    xcd_barrier(xbar);
#if !defined(ONLY) || ONLY == 5
    REPS(5)
    {
        pg8::StaticOrder S; S.init(MT / 256, DM / 256, G, bx);
        AMapStd AM{(const char*)MIX, (size_t)256 * DM * 2, (size_t)128 * DM * 2};
        Epi5 E{a.in[0], a.in[1], X1, X1B, RSQ, rep_ == 0};
        pg8::gemm_phase(lds, WoutT, DM, S, AM, E);
        if (bx >= 4) cache_copy(a, CC_1, CC_2, bx - 4, G - 4, threadIdx.x);
    }
#endif
    xcd_barrier(xbar);
#if !defined(ONLY) || ONLY == 6
    REPS(6)
    {
        pg8::StaticOrder S; S.init(69, NUP / 256, G, bx);
        AMapUp AM{(const char*)X1B};
        Epi6 E{RSQ, a.in[13], a.in[14], a.in[5], GB, a.out};
        pg8::gemm_phase(lds, WupT, DM, S, AM, E);
    }
#endif
    xcd_barrier(xbar);
#if !defined(ONLY) || ONLY == 7
    {
        pg8::StaticOrder S; S.init(MT / 256, DM / 256, G, bx);
        AMapStd AM{(const char*)GB, (size_t)256 * DFF * 2, (size_t)128 * DFF * 2};
        Epi7 E{X1B, a.out + O_Y, RSQ2, (unsigned*)(ws + WS_CNT), a.in[16], &a, bx - 4, bx >= 4 ? G - 4 : 0, CC_2, CC_TOT};
        pg8::gemm_phase(lds, WdnT, DFF, S, AM, E);
    }
#endif
}

extern "C" void kernel_launch(void* const* d_in, const int* in_sizes, int n_in, void* d_out, int out_size, void* d_ws, size_t ws_size, hipStream_t stream) {
    static int grid_blocks = 0;
    if (grid_blocks == 0) {
        if (n_in != 17 || ws_size < WS_END) { fprintf(stderr, "kernel_launch: unexpected n_in %d / ws %zu\n", n_in, ws_size); grid_blocks = -1; return; }
        int dev = 0, cus = 0, per_cu = 0;
        hipGetDevice(&dev);
        hipDeviceGetAttribute(&cus, hipDeviceAttributeMultiprocessorCount, dev);
        if (hipFuncSetAttribute((const void*)fwd, hipFuncAttributeMaxDynamicSharedMemorySize, LDS_BYTES) != hipSuccess) { fprintf(stderr, "kernel_launch: hipFuncSetAttribute failed\n"); grid_blocks = -1; return; }
        if (hipOccupancyMaxActiveBlocksPerMultiprocessor(&per_cu, (const void*)fwd, 512, LDS_BYTES) != hipSuccess || per_cu < 1) { fprintf(stderr, "kernel_launch: occupancy query gives %d\n", per_cu); (void)hipGetLastError(); per_cu = 1; }
        grid_blocks = cus * per_cu;
    }
    if (grid_blocks < 0) return;
    if (hipMemsetAsync((char*)d_ws + WS_BAR, 0, BAR_ZERO_BYTES, stream) != hipSuccess) { fprintf(stderr, "kernel_launch: memset failed\n"); return; }
    Args a{};
    for (int i = 0; i < 17; ++i) a.in[i] = (const float*)d_in[i];
    a.out = (float*)d_out; a.ws = (unsigned char*)d_ws;
    void* args[] = {&a};
    hipError_t e = hipLaunchCooperativeKernel((const void*)fwd, dim3(grid_blocks), dim3(512), args, LDS_BYTES, stream);
    if (e != hipSuccess) fprintf(stderr, "cooperative launch failed: %s (grid %d)\n", hipGetErrorString(e), grid_blocks);
}
```
